# Optimizing an MI355X kernel written in HIP

```python
import numpy as np
import jax, jax.numpy as jnp
from jax import lax

D_MODEL = 1024
BATCH = 32
SEQ = 2048
DEPTH = 2

D_HEAD = 64
ATT_DIM = 3 * D_MODEL // 8
ATT_HEADS = ATT_DIM // D_HEAD
GLA_DV = 64
GLA_DK = 32
GLA_VDIM = 3 * D_MODEL // 8
GLA_HEADS = GLA_VDIM // GLA_DV
GLA_KDIM = GLA_HEADS * GLA_DK
GLA_RANK = 16
GLA_TAU = 16.0
GLA_CHUNK = 64
SG_DIM = D_MODEL - ATT_DIM - GLA_VDIM
SG_GROUP_DIM = 64
SG_GROUPS = SG_DIM // SG_GROUP_DIM
SG_CHUNK = 128
MIX_DIM = ATT_DIM + GLA_VDIM + SG_DIM
DILATIONS = ((128, 1), (512, 4), (2048, 16))
ATT_BLOCK = 128
ROPE_THETA = 500000.0
ROPE_DIM = D_HEAD // 4
D_FF = 4 * D_MODEL
EPS = 1e-6
MASK_VALUE = -1e30
IN_SPLITS = (ATT_DIM, ATT_DIM, ATT_DIM, GLA_KDIM, GLA_KDIM, GLA_VDIM, GLA_VDIM, GLA_RANK, 2 * SG_DIM)
IN_DIM = sum(IN_SPLITS)

kernel_name = "hymba_style_gla_gmlp_dilated_hybrid"


def rms_norm(x, g):
    xf = x.astype(jnp.float32)
    y = xf * lax.rsqrt(jnp.mean(xf * xf, axis=-1, keepdims=True) + EPS)
    return (y * g.astype(jnp.float32)).astype(x.dtype)


def layer_norm(x, g, b):
    xf = x.astype(jnp.float32)
    mu = jnp.mean(xf, axis=-1, keepdims=True)
    xc = xf - mu
    y = xc * lax.rsqrt(jnp.mean(xc * xc, axis=-1, keepdims=True) + EPS)
    return (y * g.astype(jnp.float32) + b.astype(jnp.float32)).astype(x.dtype)


def rope_tables(seq):
    inv = ROPE_THETA ** (-jnp.arange(0, ROPE_DIM, 2, dtype=jnp.float32) / ROPE_DIM)
    ang = jnp.arange(seq, dtype=jnp.float32)[:, None] * inv[None, :]
    return jnp.cos(ang), jnp.sin(ang)


def partial_rope(x, cos, sin):
    half = ROPE_DIM // 2
    c = cos[None, :, None, :].astype(x.dtype)
    s = sin[None, :, None, :].astype(x.dtype)
    x1, x2, rest = x[..., :half], x[..., half:ROPE_DIM], x[..., ROPE_DIM:]
    return jnp.concatenate([x1 * c - x2 * s, x2 * c + x1 * s, rest], axis=-1)


def dilated_branch(q, k, v, window, dilation):
    B, S, H, Dh = q.shape
    n = S // dilation
    nb = -(-n // ATT_BLOCK)
    pad = nb * ATT_BLOCK - n
    span = window // dilation

    def to_sub(t):
        t = t.reshape(B, n, dilation, H, Dh).transpose(0, 2, 3, 1, 4)
        t = jnp.pad(t, ((0, 0), (0, 0), (0, 0), (0, pad), (0, 0)))
        return t.reshape(B, dilation, H, nb, ATT_BLOCK, Dh)

    def with_prev(t):
        prev = jnp.pad(t, ((0, 0), (0, 0), (0, 0), (1, 0), (0, 0), (0, 0)))[:, :, :, :-1]
        return jnp.concatenate([prev, t], axis=4)

    qs = to_sub(q)
    kb = with_prev(to_sub(k))
    vb = with_prev(to_sub(v))
    s = jnp.einsum('bdhnqc,bdhnkc->bdhnqk', qs, kb).astype(jnp.float32)
    qi = jnp.arange(ATT_BLOCK)[:, None] + ATT_BLOCK
    kj = jnp.arange(2 * ATT_BLOCK)[None, :]
    dist = qi - kj
    kpos = jnp.arange(nb)[:, None, None] * ATT_BLOCK + kj[None] - ATT_BLOCK
    valid = (dist >= 0) & (dist <= span) & (kpos >= 0)
    s = jnp.where(valid, s, MASK_VALUE)
    lse = jax.nn.logsumexp(s, axis=-1)
    p = jnp.exp(s - lse[..., None]).astype(v.dtype)
    o = jnp.einsum('bdhnqk,bdhnkc->bdhnqc', p, vb)
    o = o.reshape(B, dilation, H, nb * ATT_BLOCK, Dh)[:, :, :, :n]
    o = o.transpose(0, 3, 1, 2, 4).reshape(B, S, H, Dh)
    lse = lse.reshape(B, dilation, H, nb * ATT_BLOCK)[:, :, :, :n]
    lse = lse.transpose(0, 3, 1, 2).reshape(B, S, H)
    return o, lse


def dilated_attention(q, k, v, cos, sin, q_norm_g, k_norm_g):
    q = partial_rope(rms_norm(q, q_norm_g), cos, sin) * (D_HEAD ** -0.5)
    k = partial_rope(rms_norm(k, k_norm_g), cos, sin)
    outs, lses = [], []
    for window, dilation in DILATIONS:
        o, l = dilated_branch(q, k, v, window, dilation)
        outs.append(o)
        lses.append(l)
    wts = jax.nn.softmax(jnp.stack(lses, axis=0), axis=0).astype(v.dtype)
    o = jnp.einsum('rbsh,rbshc->bshc', wts, jnp.stack(outs, axis=0))
    B, S = o.shape[:2]
    return o.reshape(B, S, ATT_DIM)


def gated_linear_attention(q, k, v, r, a_lr, w_a2, b_a, g_norm):
    B, S = q.shape[:2]
    C = GLA_CHUNK
    N = S // C
    f32 = jnp.float32
    gk = jax.nn.log_sigmoid((a_lr @ w_a2 + b_a).astype(f32)) / GLA_TAU
    bcum = jnp.cumsum(gk.reshape(B, N, C, GLA_HEADS, GLA_DK), axis=2)
    qf = q.astype(f32).reshape(B, N, C, GLA_HEADS, GLA_DK) * (GLA_DK ** -0.5)
    kf = k.astype(f32).reshape(B, N, C, GLA_HEADS, GLA_DK)
    vf = v.astype(f32).reshape(B, N, C, GLA_HEADS, GLA_DV)
    b_last = bcum[:, :, -1:]
    q_t = qf * jnp.exp(bcum)
    k_t = kf * jnp.exp(-bcum)
    k_end = kf * jnp.exp(b_last - bcum)
    causal = jnp.tril(jnp.ones((C, C), dtype=bool))
    A = jnp.where(causal, jnp.einsum('bnthk,bnshk->bnhts', q_t, k_t), 0.0)
    o_intra = jnp.einsum('bnhts,bnshv->bnthv', A, vf)
    kv = jnp.einsum('bnshk,bnshv->nbhkv', k_end, vf)
    decay = jnp.exp(b_last[:, :, 0]).transpose(1, 0, 2, 3)

    def step(state, inp):
        dec, kv_n = inp
        return state * dec[..., None] + kv_n, state

    _, states = lax.scan(step, jnp.zeros((B, GLA_HEADS, GLA_DK, GLA_DV), f32), (decay, kv))
    o_inter = jnp.einsum('bnthk,nbhkv->bnthv', q_t, states)
    o = (o_intra + o_inter).reshape(B, S, GLA_HEADS, GLA_DV)
    o = rms_norm(o, g_norm) * jax.nn.silu(r.astype(f32))
    return o.reshape(B, S, GLA_VDIM).astype(q.dtype)


def spatial_gating(z, ln_g, ln_b, w_s, b_s):
    B, S, _ = z.shape
    N = S // SG_CHUNK
    z = jax.nn.gelu(z)
    u, v = jnp.split(z, 2, axis=-1)
    v = layer_norm(v, ln_g, ln_b).reshape(B, N, SG_CHUNK, SG_GROUPS, SG_GROUP_DIM)
    causal = jnp.tril(jnp.ones((SG_CHUNK, SG_CHUNK), dtype=bool))
    w = jnp.where(causal, w_s, jnp.zeros_like(w_s))
    s = jnp.einsum('gts,bnsgc->bntgc', w, v) + b_s.T[None, None, :, :, None]
    return u * s.reshape(B, S, SG_DIM)


def hybrid_mixer(h, cos, sin, w_in, q_norm_g, k_norm_g, gla_w_a2, gla_b_a, gla_norm_g,
                 sg_ln_g, sg_ln_b, sg_w, sg_b, w_out):
    B, S, _ = h.shape
    proj = h @ w_in
    split_points = np.cumsum(IN_SPLITS)[:-1].tolist()
    q_a, k_a, v_a, q_g, k_g, v_g, r_g, a_g, z_s = jnp.split(proj, split_points, axis=-1)
    o_att = dilated_attention(q_a.reshape(B, S, ATT_HEADS, D_HEAD), k_a.reshape(B, S, ATT_HEADS, D_HEAD),
                              v_a.reshape(B, S, ATT_HEADS, D_HEAD), cos, sin, q_norm_g, k_norm_g)
    o_gla = gated_linear_attention(q_g, k_g, v_g.reshape(B, S, GLA_HEADS, GLA_DV),
                                   r_g.reshape(B, S, GLA_HEADS, GLA_DV), a_g, gla_w_a2, gla_b_a, gla_norm_g)
    o_sg = spatial_gating(z_s, sg_ln_g, sg_ln_b, sg_w, sg_b)
    return jnp.concatenate([o_att, o_gla, o_sg], axis=-1) @ w_out


def squared_relu_mlp(h, w1, w2):
    return jnp.square(jax.nn.relu(h @ w1)) @ w2


def setup_inputs(seed: int = 0) -> dict:
    key = jax.random.key(seed)
    ks = jax.random.split(key, 18)
    nrm = lambda k, shape, scale: jax.random.normal(k, shape, jnp.float32) * scale
    return {
        "x": nrm(ks[0], (BATCH, SEQ, D_MODEL), 1.0),
        "norm1_g": 1.0 + nrm(ks[1], (DEPTH, D_MODEL), 0.02),
        "w_in": nrm(ks[2], (DEPTH, D_MODEL, IN_DIM), D_MODEL ** -0.5),
        "q_norm_g": 1.0 + nrm(ks[3], (DEPTH, D_HEAD), 0.02),
        "k_norm_g": 1.0 + nrm(ks[4], (DEPTH, D_HEAD), 0.02),
        "gla_w_a2": nrm(ks[5], (DEPTH, GLA_RANK, GLA_KDIM), GLA_RANK ** -0.5),
        "gla_b_a": nrm(ks[6], (DEPTH, GLA_KDIM), 0.1),
        "gla_norm_g": 1.0 + nrm(ks[7], (DEPTH, GLA_DV), 0.02),
        "sg_ln_g": 1.0 + nrm(ks[8], (DEPTH, SG_DIM), 0.02),
        "sg_ln_b": nrm(ks[9], (DEPTH, SG_DIM), 0.02),
        "sg_w": nrm(ks[10], (DEPTH, SG_GROUPS, SG_CHUNK, SG_CHUNK), SG_CHUNK ** -0.5),
        "sg_b": 1.0 + nrm(ks[11], (DEPTH, SG_GROUPS, SG_CHUNK), 0.02),
        "w_out": nrm(ks[12], (DEPTH, MIX_DIM, D_MODEL), MIX_DIM ** -0.5),
        "norm2_g": 1.0 + nrm(ks[13], (DEPTH, D_MODEL), 0.02),
        "w_ff1": nrm(ks[14], (DEPTH, D_MODEL, D_FF), D_MODEL ** -0.5),
        "w_ff2": nrm(ks[15], (DEPTH, D_FF, D_MODEL), D_FF ** -0.5),
    }


def reference(x, norm1_g, w_in, q_norm_g, k_norm_g, gla_w_a2, gla_b_a, gla_norm_g,
              sg_ln_g, sg_ln_b, sg_w, sg_b, w_out, norm2_g, w_ff1, w_ff2):
    cos, sin = rope_tables(x.shape[1])
    for l in range(DEPTH):
        h = rms_norm(x, norm1_g[l])
        x = x + hybrid_mixer(h, cos, sin, w_in[l], q_norm_g[l], k_norm_g[l], gla_w_a2[l], gla_b_a[l],
                             gla_norm_g[l], sg_ln_g[l], sg_ln_b[l], sg_w[l], sg_b[l], w_out[l])
        x = x + squared_relu_mlp(rms_norm(x, norm2_g[l]), w_ff1[l], w_ff2[l])
    return x
```

```cpp
#include <hip/hip_runtime.h>
#include <cstdio>
#include <cstdint>
namespace pg8 {
#define PG8_LAS __attribute__((address_space(3)))
typedef unsigned short bf16_t;
typedef short bf16x8 __attribute__((ext_vector_type(8)));
typedef float f32x4 __attribute__((ext_vector_type(4)));
typedef unsigned u32x4 __attribute__((ext_vector_type(4)));
constexpr int BM = 256, BK = 64, HALF = 128, HTB = HALF * BK * 2  , STAGE_BYTES = 8 * HTB, NXCD = 8, WGM = 8;

__host__ __device__ __forceinline__ int lds_byte(int r, int c) { const int st = (r >> 4) * 2 + (c >> 5), rr = r & 15, cc = c & 31, ob = rr * 64 + cc * 2; return st * 1024 + (ob ^ (((ob >> 9) & 1) << 5)); }
__host__ __device__ __forceinline__ void stage_rc(int b, int& R, int& C) { const int st = b / 1024, sb = b % 1024, swz = sb ^ (((sb >> 9) & 1) << 5); R = (st >> 1) * 16 + swz / 64; C = (st & 1) * 32 + (swz % 64) / 2; }
__host__ __device__ __forceinline__ int perm32(int rho) { const int n = rho >> 4, i = rho & 15; return 8 * (i >> 2) + 4 * n + (i & 3); }

struct Unit { int pm, pn; };
struct Gemm { const bf16_t* A; const bf16_t* Bt; int M, N, K; };

struct StaticOrder {
    int nM, nN, nwg, G, c;
    __host__ __device__ void init(int M, int N, int G_, int c_) { nM = M / BM; nN = N / BM; nwg = nM * nN; G = G_; c = c_; }
    __host__ __device__ bool next(int i, Unit& u) const {
        const long L = (long)i * G + c; if (L >= nwg) return false;
        int wgid = (int)L; { const int q = nwg / NXCD, r = nwg % NXCD, xcd = wgid % NXCD, off = wgid / NXCD; wgid = (xcd < r ? xcd * (q + 1) : r * (q + 1) + (xcd - r) * q) + off; }
        const int nig = WGM * nN, gid = wgid / nig, fm = gid * WGM, gsz = (nM - fm) < WGM ? (nM - fm) : WGM;
        u.pm = fm + ((wgid % nig) % gsz); u.pn = (wgid % nig) / gsz; return true;
    }
    __device__ __forceinline__ void a_ready(const Unit&) const {}
    __device__ __forceinline__ void done(const Unit&) const {}
};

typedef float f32x2_t __attribute__((ext_vector_type(2))); typedef __bf16 bf16x2_t __attribute__((ext_vector_type(2)));
__device__ __forceinline__ unsigned cvt_pk_bf16(float lo, float hi) { const f32x2_t v = {lo, hi}; return __builtin_bit_cast(unsigned, __builtin_convertvector(v, bf16x2_t)); }
constexpr int SSQ_M = 65536;
__device__ __forceinline__ float row_rstd(const float* ssq, int row, int fq, float inv_n, float eps) {
    const f32x4 p = *(const f32x4*)(ssq + (size_t)row * 16 + 4 * fq);
    float s = (p[0] + p[1]) + (p[2] + p[3]);
    s += __shfl_xor(s, 16); s += __shfl_xor(s, 32);
    return 1.0f / sqrtf(s * inv_n + eps);
}
template <int ACT> struct EpiScaleBf16 {
    static constexpr bool PERM = true, AFTER_DRAIN = false;
    bf16_t* O; int ldc; const float* ssq; float inv_n, eps;
    __device__ __forceinline__ void operator()(const f32x4 (&acc)[2][2][4][2], const Unit& u, int wr, int wc, int fr, int fq) const {
        const int row0 = u.pm * BM + wr * 64 + fr, col0 = u.pn * BM + wc * 32 + 8 * fq;
#pragma unroll
        for (int ai = 0; ai < 2; ++ai)
#pragma unroll
            for (int m = 0; m < 4; ++m) {
                const int row = row0 + ai * HALF + m * 16;
                const float rs = row_rstd(ssq, row, fq, inv_n, eps);
                bf16_t* rowp = O + (size_t)row * ldc + col0;
#pragma unroll
                for (int bj = 0; bj < 2; ++bj) {
                    f32x4 v0 = acc[ai][bj][m][0] * rs, v1 = acc[ai][bj][m][1] * rs;
                    if (ACT == 1) {
#pragma unroll
                        for (int e = 0; e < 4; ++e) { const float a = fmaxf(v0[e], 0.f), b = fmaxf(v1[e], 0.f); v0[e] = a * a; v1[e] = b * b; }
                    }
                    u32x4 w; w.x = cvt_pk_bf16(v0[0], v0[1]); w.y = cvt_pk_bf16(v0[2], v0[3]); w.z = cvt_pk_bf16(v1[0], v1[1]); w.w = cvt_pk_bf16(v1[2], v1[3]);
                    *(u32x4*)(rowp + bj * HALF) = w;
                }
            }
    }
};
struct EpiProj {
    static constexpr bool PERM = true, AFTER_DRAIN = false;
    bf16_t* O; int ldc; const float* ssq; const float* qg; const float* kg; const float* rope; float inv_n, eps;
    __device__ __forceinline__ void operator()(const f32x4 (&acc)[2][2][4][2], const Unit& u, int wr, int wc, int fr, int fq) const {
        const int row0 = u.pm * BM + wr * 64 + fr, colh = u.pn * BM + wc * 64 + 8 * fq;
        const bool qk = u.pn < 3;
        f32x4 g00 = {1.f, 1.f, 1.f, 1.f}, g01 = g00, g10 = g00, g11 = g00; float sc = 1.f;
        if (qk) { const int hg = 4 * u.pn + wc; const float* g = hg < 6 ? qg : kg; sc = hg < 6 ? 0.125f : 1.0f;
            const int d0 = fq < 2 ? 4 * fq : 8 * fq, d1 = fq < 2 ? 4 * fq + 8 : 8 * fq + 4;
            g00 = *(const f32x4*)(g + d0); g01 = *(const f32x4*)(g + d1); g10 = *(const f32x4*)(g + 32 + 8 * fq); g11 = *(const f32x4*)(g + 36 + 8 * fq); }
#pragma unroll
        for (int ai = 0; ai < 2; ++ai)
#pragma unroll
            for (int m = 0; m < 4; ++m) {
                const int row = row0 + ai * HALF + m * 16;
                const float rs = row_rstd(ssq, row, fq, inv_n, eps);
                f32x4 v00 = acc[ai][0][m][0] * rs, v01 = acc[ai][0][m][1] * rs, v10 = acc[ai][1][m][0] * rs, v11 = acc[ai][1][m][1] * rs;
                if (qk) {
                    float ss = 0.f;
#pragma unroll
                    for (int e = 0; e < 4; ++e) ss += (v00[e] * v00[e] + v01[e] * v01[e]) + (v10[e] * v10[e] + v11[e] * v11[e]);
                    ss += __shfl_xor(ss, 16); ss += __shfl_xor(ss, 32);
                    const float r = sc / sqrtf(ss * (1.0f / 64.0f) + eps);
                    v00 = v00 * (g00 * r); v01 = v01 * (g01 * r); v10 = v10 * (g10 * r); v11 = v11 * (g11 * r);
                    const int t = row & 2047;
                    const f32x4 cs = *(const f32x4*)(rope + t * 16 + 4 * (fq & 1)), sn = *(const f32x4*)(rope + t * 16 + 8 + 4 * (fq & 1));
                    const f32x4 ra = v00 * cs - v01 * sn, rb = v01 * cs + v00 * sn;
                    if (fq < 2) { v00 = ra; v01 = rb; }
                }
                bf16_t* rowp = O + (size_t)row * ldc + colh;
                u32x4 w; w.x = cvt_pk_bf16(v00[0], v00[1]); w.y = cvt_pk_bf16(v00[2], v00[3]); w.z = cvt_pk_bf16(v01[0], v01[1]); w.w = cvt_pk_bf16(v01[2], v01[3]);
                *(u32x4*)(rowp) = w;
                w.x = cvt_pk_bf16(v10[0], v10[1]); w.y = cvt_pk_bf16(v10[2], v10[3]); w.z = cvt_pk_bf16(v11[0], v11[1]); w.w = cvt_pk_bf16(v11[2], v11[3]);
                *(u32x4*)(rowp + 32) = w;
            }
    }
};
struct EpiResidDry {
    static constexpr bool PERM = true, AFTER_DRAIN = false;
    const float* base; bf16_t* xb; int ldc;
    __device__ __forceinline__ void operator()(const f32x4 (&acc)[2][2][4][2], const Unit& u, int wr, int wc, int fr, int fq) const {
        const int row0 = u.pm * BM + wr * 64 + fr, col0 = u.pn * BM + wc * 32 + 8 * fq;
#pragma unroll
        for (int ai = 0; ai < 2; ++ai)
#pragma unroll
            for (int m = 0; m < 4; ++m) {
                const int row = row0 + ai * HALF + m * 16;
                const size_t off = (size_t)row * ldc + col0;
#pragma unroll
                for (int bj = 0; bj < 2; ++bj) {
                    const f32x4 b0 = *(const f32x4*)(base + off + bj * HALF), b1 = *(const f32x4*)(base + off + bj * HALF + 4);
                    const f32x4 v0 = acc[ai][bj][m][0] + b0, v1 = acc[ai][bj][m][1] + b1;
                    u32x4 w; w.x = cvt_pk_bf16(v0[0], v0[1]); w.y = cvt_pk_bf16(v0[2], v0[3]); w.z = cvt_pk_bf16(v1[0], v1[1]); w.w = cvt_pk_bf16(v1[2], v1[3]);
                    *(u32x4*)(xb + off + bj * HALF) = w;
                }
                asm volatile("" ::: "memory");
            }
    }
};
struct EpiResidB {
    static constexpr bool PERM = true, AFTER_DRAIN = false;
    bf16_t* xb; float* ssq; float* outf; int ldc;
    __device__ __forceinline__ void operator()(const f32x4 (&acc)[2][2][4][2], const Unit& u, int wr, int wc, int fr, int fq) const {
        const int row0 = u.pm * BM + wr * 64 + fr, col0 = u.pn * BM + wc * 32 + 8 * fq;
#pragma unroll
        for (int ai = 0; ai < 2; ++ai)
#pragma unroll
            for (int m = 0; m < 4; ++m) {
                const int row = row0 + ai * HALF + m * 16;
                const size_t off = (size_t)row * ldc + col0;
                float s = 0.f;
#pragma unroll
                for (int bj = 0; bj < 2; ++bj) {
                    const u32x4 xo = *(const u32x4*)(xb + off + bj * HALF);
                    const f32x4 b0 = {__uint_as_float(xo.x << 16), __uint_as_float(xo.x & 0xffff0000u), __uint_as_float(xo.y << 16), __uint_as_float(xo.y & 0xffff0000u)};
                    const f32x4 b1 = {__uint_as_float(xo.z << 16), __uint_as_float(xo.z & 0xffff0000u), __uint_as_float(xo.w << 16), __uint_as_float(xo.w & 0xffff0000u)};
                    const f32x4 v0 = acc[ai][bj][m][0] + b0, v1 = acc[ai][bj][m][1] + b1;
                    if (outf) { *(f32x4*)(outf + off + bj * HALF) = v0; *(f32x4*)(outf + off + bj * HALF + 4) = v1; }
                    else {
                        u32x4 w; w.x = cvt_pk_bf16(v0[0], v0[1]); w.y = cvt_pk_bf16(v0[2], v0[3]); w.z = cvt_pk_bf16(v1[0], v1[1]); w.w = cvt_pk_bf16(v1[2], v1[3]);
                        *(u32x4*)(xb + off + bj * HALF) = w;
                        s += (v0[0] * v0[0] + v0[1] * v0[1]) + (v0[2] * v0[2] + v0[3] * v0[3]) + (v1[0] * v1[0] + v1[1] * v1[1]) + (v1[2] * v1[2] + v1[3] * v1[3]); }
                }
                if (!outf) { s += __shfl_xor(s, 16); s += __shfl_xor(s, 32);
                    if (fq == 0) ssq[(size_t)row * 16 + 4 * u.pn + wc] = s; }
                asm volatile("" ::: "memory");
            }
    }
};
struct EpiResid {
    static constexpr bool PERM = true, AFTER_DRAIN = false;
    const float* base; float* out; bf16_t* xb; float* ssq; int ldc;
    __device__ __forceinline__ void operator()(const f32x4 (&acc)[2][2][4][2], const Unit& u, int wr, int wc, int fr, int fq) const {
        const int row0 = u.pm * BM + wr * 64 + fr, col0 = u.pn * BM + wc * 32 + 8 * fq;
#pragma unroll
        for (int ai = 0; ai < 2; ++ai)
#pragma unroll
            for (int m = 0; m < 4; ++m) {
                const int row = row0 + ai * HALF + m * 16;
                const size_t off = (size_t)row * ldc + col0;
                float s = 0.f;
#pragma unroll
                for (int bj = 0; bj < 2; ++bj) {
                    const f32x4 b0 = *(const f32x4*)(base + off + bj * HALF), b1 = *(const f32x4*)(base + off + bj * HALF + 4);
                    const f32x4 v0 = acc[ai][bj][m][0] + b0, v1 = acc[ai][bj][m][1] + b1;
                    *(f32x4*)(out + off + bj * HALF) = v0; *(f32x4*)(out + off + bj * HALF + 4) = v1;
                    u32x4 w; w.x = cvt_pk_bf16(v0[0], v0[1]); w.y = cvt_pk_bf16(v0[2], v0[3]); w.z = cvt_pk_bf16(v1[0], v1[1]); w.w = cvt_pk_bf16(v1[2], v1[3]);
                    *(u32x4*)(xb + off + bj * HALF) = w;
                    s += (v0[0] * v0[0] + v0[1] * v0[1]) + (v0[2] * v0[2] + v0[3] * v0[3]) + (v1[0] * v1[0] + v1[1] * v1[1]) + (v1[2] * v1[2] + v1[3] * v1[3]);
                }
                s += __shfl_xor(s, 16); s += __shfl_xor(s, 32);
                if (fq == 0) ssq[((size_t)u.pn * SSQ_M + row) * 4 + wc] = s;
                asm volatile("" ::: "memory");
            }
    }
};
template <class Epi, class Sched, bool ALIGN_EPI = false, bool SP2 = false>
__device__ __forceinline__ void gemm_phase(PG8_LAS unsigned char* lds, const Gemm g, const Sched& S, const Epi& E) {
    int tid = threadIdx.x; asm volatile("" : "+v"(tid));
    const int wid = __builtin_amdgcn_readfirstlane(tid >> 6), lane = tid & 63, wr = wid >> 2, wc = wid & 3, fr = lane & 15, fq = lane >> 4;
    const int K = g.K, nt = K / BK;
    unsigned voffA[2], voffB[2];
#pragma unroll
    for (int i = 0; i < 2; ++i) { int R, C; stage_rc(tid * 16 + i * 8192, R, C); const int Rb = Epi::PERM ? ((R & ~31) + perm32(R & 31)) : R;
        voffA[i] = (unsigned)(R * K + C) * 2u; voffB[i] = (unsigned)(Rb * K + C) * 2u; }
    const size_t kstep = (size_t)(BK * 2);
    const size_t hstep = (size_t)HALF * K * 2;
    const size_t tstep = 2 * hstep;
    const unsigned ldsw = (unsigned)wid * 1024u;
    const int aoff = lds_byte(wr * 64 + fr, fq * 8), boff = lds_byte(wc * 32 + fr, fq * 8);
#define PG8_SA(b, h) (((b) * 2 + (h)) * HTB)
#define PG8_SB(b, h) ((4 + (b) * 2 + (h)) * HTB)
#define PG8_STAGE(bufoff, gbase, voff) do { _Pragma("unroll") for (int _i = 0; _i < 2; ++_i) \
        __builtin_amdgcn_global_load_lds((const unsigned*)((const char*)(gbase) + (voff)[_i]), (PG8_LAS unsigned*)(lds + (bufoff) + ldsw + _i * 8192), 16, 0, 0); } while (0)
#define PG8_LDA(dst, b, h) do { _Pragma("unroll") for (int m = 0; m < 4; ++m) _Pragma("unroll") for (int k = 0; k < 2; ++k) dst[m][k] = *(const PG8_LAS bf16x8*)(lds + PG8_SA(b, h) + aoff + m * 2048 + k * 1024); } while (0)
#define PG8_LDB(dst, b, h) do { _Pragma("unroll") for (int n = 0; n < 2; ++n) _Pragma("unroll") for (int k = 0; k < 2; ++k) dst[n][k] = *(const PG8_LAS bf16x8*)(lds + PG8_SB(b, h) + boff + n * 2048 + k * 1024); } while (0)
#define PG8_MMA(ai, bj, At, Bt) do { __builtin_amdgcn_s_setprio(1); _Pragma("unroll") for (int m = 0; m < 4; ++m) _Pragma("unroll") for (int n = 0; n < 2; ++n) _Pragma("unroll") for (int k = 0; k < 2; ++k) \
        acc[ai][bj][m][n] = __builtin_amdgcn_mfma_f32_16x16x32_bf16(Bt[n][k], At[m][k], acc[ai][bj][m][n], 0, 0, 0); __builtin_amdgcn_s_setprio(0); } while (0)
#define PG8_WAIT_V(n) asm volatile("s_waitcnt vmcnt(" #n ")" ::: "memory")
#define PG8_WAIT_L(n) asm volatile("s_waitcnt lgkmcnt(" #n ")" ::: "memory")
#define PG8_BAR __builtin_amdgcn_s_barrier()
#define PG8_SCHED __builtin_amdgcn_sched_barrier(0)
    Unit cur, nxt; int ui = 0;
    if (!S.next(0, cur)) return;
    f32x4 acc[2][2][4][2];
#pragma unroll
    for (int a = 0; a < 2; ++a)
#pragma unroll
        for (int b = 0; b < 2; ++b)
#pragma unroll
            for (int m = 0; m < 4; ++m)
#pragma unroll
                for (int n = 0; n < 2; ++n) acc[a][b][m][n] = (f32x4){0.f, 0.f, 0.f, 0.f};
    bf16x8 At[4][2], B0[2][2], B1[2][2];
    const char* cA = (const char*)g.A + (size_t)cur.pm * tstep; const char* cB = (const char*)g.Bt + (size_t)cur.pn * tstep;
    S.a_ready(cur);
    if constexpr (SP2) {
        PG8_STAGE(PG8_SB(0, 0), cB, voffB); PG8_STAGE(PG8_SB(0, 1), cB + hstep, voffB); PG8_STAGE(PG8_SA(0, 0), cA, voffA); PG8_STAGE(PG8_SA(0, 1), cA + hstep, voffA);
        if (wr == 1) PG8_BAR;
        PG8_WAIT_V(2); PG8_BAR;
        PG8_STAGE(PG8_SB(1, 0), cB + kstep, voffB); PG8_STAGE(PG8_SA(1, 0), cA + kstep, voffA); PG8_STAGE(PG8_SB(1, 1), cB + hstep + kstep, voffB);
        PG8_WAIT_V(6); PG8_BAR;
    } else {
        PG8_STAGE(PG8_SB(0, 0), cB, voffB); PG8_STAGE(PG8_SA(0, 0), cA, voffA); PG8_STAGE(PG8_SB(0, 1), cB + hstep, voffB); PG8_STAGE(PG8_SA(0, 1), cA + hstep, voffA);
        if (wr == 1) PG8_BAR;
        PG8_WAIT_V(4); PG8_BAR;
        PG8_STAGE(PG8_SB(1, 0), cB + kstep, voffB); PG8_STAGE(PG8_SA(1, 0), cA + kstep, voffA); PG8_STAGE(PG8_SB(1, 1), cB + hstep + kstep, voffB);
        PG8_WAIT_V(6); PG8_BAR;
    }
    for (;;) {
        const bool has_next = S.next(ui + 1, nxt);
        const char* nA = has_next ? (const char*)g.A + (size_t)nxt.pm * tstep : cA; const char* nB = has_next ? (const char*)g.Bt + (size_t)nxt.pn * tstep : cB;
        for (int t = 0; t < nt; t += 2) {
            const bool last = (t == nt - 2);
            const char* a1 = cA + (size_t)(t + 1) * kstep;
            const char* a2 = last ? nA : cA + (size_t)(t + 2) * kstep; const char* b2 = last ? nB : cB + (size_t)(t + 2) * kstep;
            const char* a3 = a2 + kstep; const char* b3 = b2 + kstep;
            if (last && has_next) S.a_ready(nxt);
            if constexpr (SP2) {
            PG8_LDB(B0, 0, 0); PG8_LDB(B1, 0, 1); PG8_SCHED; PG8_LDA(At, 0, 0); PG8_STAGE(PG8_SA(1, 1), a1 + hstep, voffA);
            PG8_WAIT_V(8); PG8_WAIT_L(0); PG8_BAR; PG8_MMA(0, 0, At, B0); PG8_MMA(0, 1, At, B1); PG8_BAR; PG8_SCHED;
            PG8_LDA(At, 0, 1); PG8_STAGE(PG8_SB(0, 0), b2, voffB); PG8_STAGE(PG8_SB(0, 1), b2 + hstep, voffB); PG8_STAGE(PG8_SA(0, 0), a2, voffA);
            PG8_WAIT_V(8); PG8_WAIT_L(0); PG8_BAR; PG8_MMA(1, 0, At, B0); PG8_MMA(1, 1, At, B1); PG8_BAR; PG8_SCHED;
            PG8_LDB(B0, 1, 0); PG8_LDB(B1, 1, 1); PG8_SCHED; PG8_LDA(At, 1, 0); PG8_STAGE(PG8_SA(0, 1), a2 + hstep, voffA);
            PG8_WAIT_V(8); PG8_WAIT_L(0); PG8_BAR; PG8_MMA(0, 0, At, B0); PG8_MMA(0, 1, At, B1); PG8_BAR; PG8_SCHED;
            PG8_LDA(At, 1, 1); PG8_STAGE(PG8_SB(1, 0), b3, voffB); PG8_STAGE(PG8_SB(1, 1), b3 + hstep, voffB); PG8_STAGE(PG8_SA(1, 0), a3, voffA);
            PG8_WAIT_V(8); PG8_WAIT_L(0); PG8_BAR; PG8_MMA(1, 0, At, B0); PG8_MMA(1, 1, At, B1); PG8_BAR; PG8_SCHED;
            } else {
            PG8_LDB(B0, 0, 0); PG8_SCHED; PG8_LDA(At, 0, 0); PG8_STAGE(PG8_SA(1, 1), a1 + hstep, voffA);
            PG8_WAIT_L(8); PG8_BAR; PG8_WAIT_L(0); PG8_MMA(0, 0, At, B0); PG8_BAR; PG8_SCHED;
            PG8_LDB(B1, 0, 1); PG8_STAGE(PG8_SB(0, 0), b2, voffB);
            PG8_BAR; PG8_WAIT_L(0); PG8_MMA(0, 1, At, B1); PG8_BAR;
            PG8_LDA(At, 0, 1); PG8_STAGE(PG8_SA(0, 0), a2, voffA);
            PG8_BAR; PG8_WAIT_L(0); PG8_MMA(1, 0, At, B0); PG8_BAR; PG8_SCHED;
            PG8_STAGE(PG8_SB(0, 1), b2 + hstep, voffB);
            PG8_WAIT_V(6); PG8_BAR; PG8_MMA(1, 1, At, B1); PG8_BAR;
            PG8_LDB(B0, 1, 0); PG8_SCHED; PG8_LDA(At, 1, 0); PG8_STAGE(PG8_SA(0, 1), a2 + hstep, voffA);
            PG8_WAIT_L(8); PG8_BAR; PG8_WAIT_L(0); PG8_MMA(0, 0, At, B0); PG8_BAR; PG8_SCHED;
            PG8_LDB(B1, 1, 1); PG8_STAGE(PG8_SB(1, 0), b3, voffB);
            PG8_BAR; PG8_WAIT_L(0); PG8_MMA(0, 1, At, B1); PG8_BAR;
            PG8_LDA(At, 1, 1); PG8_STAGE(PG8_SA(1, 0), a3, voffA);
            PG8_BAR; PG8_WAIT_L(0); PG8_MMA(1, 0, At, B0); PG8_BAR; PG8_SCHED;
            PG8_STAGE(PG8_SB(1, 1), b3 + hstep, voffB);
            PG8_WAIT_V(6); PG8_BAR; PG8_MMA(1, 1, At, B1); PG8_BAR;
            }
        }
        if constexpr (ALIGN_EPI) { if (wr == 0) PG8_BAR; }
        if constexpr (!Epi::AFTER_DRAIN) { E(acc, cur, wr, wc, fr, fq); S.done(cur); }
        if (!has_next) break;
#pragma unroll
        for (int a = 0; a < 2; ++a)
#pragma unroll
            for (int b = 0; b < 2; ++b)
#pragma unroll
                for (int m = 0; m < 4; ++m)
#pragma unroll
                    for (int n = 0; n < 2; ++n) acc[a][b][m][n] = (f32x4){0.f, 0.f, 0.f, 0.f};
        cur = nxt; cA = nA; cB = nB; ++ui;
        if constexpr (ALIGN_EPI) { if (wr == 1) PG8_BAR; }
    }
    PG8_WAIT_V(0);
    if constexpr (!ALIGN_EPI) { if (wr == 0) PG8_BAR; }
    PG8_BAR;
    if constexpr (Epi::AFTER_DRAIN) { E.fused(acc, cur, wr, wc, fr, fq, lds, wid, lane); S.done(cur); }
#undef PG8_SA
#undef PG8_SB
#undef PG8_STAGE
#undef PG8_LDA
#undef PG8_LDB
#undef PG8_MMA
#undef PG8_WAIT_V
#undef PG8_WAIT_L
#undef PG8_BAR
#undef PG8_SCHED
}
}
constexpr int NWAVES = 8;
constexpr int BATCH = 32, SEQ = 2048, DMODEL = 1024, DEPTH = 2, FF = 4096;
constexpr int M = BATCH * SEQ;
constexpr int NPROJ = 3072, IN_DIM = 2832;
constexpr int QA = 0, KA = 384, VA = 768, QG = 1152, KG = 1344, VG = 1536, RG = 1920, ZS = 2304, AG = 2816;
constexpr float EPS = 1e-6f;
constexpr int NPHASE = 1 + 6 * DEPTH;
#ifndef MK_N_LAUNCHES
#define MK_N_LAUNCHES 1
#endif
#ifndef CUTMASK
#define CUTMASK 0
#endif
constexpr int N_LAUNCHES = MK_N_LAUNCHES;

constexpr size_t MiB = 1u << 20;
constexpr size_t WS_CTL = 0, CTL_ZERO_BYTES = 1 * MiB;
constexpr size_t WS_ROPE = 1 * MiB;
constexpr size_t WS_WSG = 1 * MiB + 256 * 1024;
constexpr size_t WS_W = 2 * MiB, W_LAYER = 24 * MiB;
constexpr size_t W_IN = 0, W_OUT = 6 * MiB, W_1 = 8 * MiB, W_2 = 16 * MiB;
constexpr size_t WS_SSQ = 50 * MiB, SSQ_STRIDE = 4 * MiB;
constexpr size_t WS_XB = 66 * MiB;
constexpr size_t WS_BC = 194 * MiB, WS_KVS = 242 * MiB;
constexpr size_t WS_DEC = 290 * MiB, DEC_STRIDE = 1 * MiB;
constexpr size_t WS_AGS = 292 * MiB, AGS_STRIDE = 6 * MiB, WS_AGD = 304 * MiB, AGD_STRIDE = 512 * 1024;
constexpr size_t WS_LSE = 305 * MiB, LSE_STRIDE = 5 * MiB;
constexpr size_t WS_PROJ = 320 * MiB, WS_MIX = 704 * MiB, WS_HID = 320 * MiB, WS_END = 832 * MiB;
constexpr size_t WS_OR = 832 * MiB, WS_END2 = WS_OR + (size_t)3 * 65536 * 384 * 2;
static_assert(WS_W + DEPTH * W_LAYER <= WS_SSQ && WS_SSQ + 4 * SSQ_STRIDE <= WS_XB && WS_XB + (size_t)M * DMODEL * 2 <= WS_BC && WS_BC + (size_t)6144 * 2048 * 4 <= WS_KVS && WS_KVS + (size_t)6144 * 2048 * 4 <= WS_DEC, "ws map");
static_assert(WS_DEC + DEPTH * DEC_STRIDE <= WS_AGS && WS_AGS + DEPTH * AGS_STRIDE <= WS_AGD && WS_AGD + DEPTH * AGD_STRIDE <= WS_LSE && WS_LSE + DEPTH * LSE_STRIDE <= WS_PROJ && (size_t)3 * 192 * 2048 * 4 <= LSE_STRIDE, "ws map");
static_assert(WS_PROJ + (size_t)M * NPROJ * 2 <= WS_MIX && WS_MIX + (size_t)M * DMODEL * 2 <= WS_END && WS_HID + (size_t)M * FF * 2 <= WS_END && WS_END2 <= 1024 * MiB, "ws map");
constexpr int CW_BAR = 4096;

constexpr int RING_OFF = 0, RING_BYTES = 131072;
constexpr int LDSCTL_OFF = RING_BYTES, MISC_OFF = LDSCTL_OFF + 320;
constexpr int LDS_BYTES = 147456;

#define GAS __attribute__((address_space(1)))
#define LAS __attribute__((address_space(3)))
typedef unsigned short bf16;
typedef unsigned v4u __attribute__((ext_vector_type(4)));
typedef unsigned v2u __attribute__((ext_vector_type(2)));
typedef float f32x4 __attribute__((ext_vector_type(4)));
typedef float f32x16 __attribute__((ext_vector_type(16)));
typedef short bf16x8 __attribute__((ext_vector_type(8)));
typedef short s16x4 __attribute__((ext_vector_type(4)));
typedef GAS unsigned gu32;
#define LDS_WAIT() asm volatile("s_waitcnt lgkmcnt(0)" ::: "memory")
#define VM_WAIT() asm volatile("s_waitcnt vmcnt(0)" ::: "memory")
__device__ __forceinline__ unsigned pk2(float lo, float hi) { return pg8::cvt_pk_bf16(lo, hi); }
__device__ __forceinline__ float bflo(unsigned w) { return __uint_as_float(w << 16); }
__device__ __forceinline__ float bfhi(unsigned w) { return __uint_as_float(w & 0xffff0000u); }
__device__ __forceinline__ float bf1(unsigned short h) { return __uint_as_float((unsigned)h << 16); }
__device__ __forceinline__ void unpack8(const v4u w, float* f) { f[0] = bflo(w.x); f[1] = bfhi(w.x); f[2] = bflo(w.y); f[3] = bfhi(w.y); f[4] = bflo(w.z); f[5] = bfhi(w.z); f[6] = bflo(w.w); f[7] = bfhi(w.w); }
__device__ __forceinline__ bf16x8 as_frag(const v4u w) { return __builtin_bit_cast(bf16x8, w); }
__device__ __forceinline__ bf16x8 tr_frag(const LAS unsigned char* p_lo, const LAS unsigned char* p_hi) {
    const s16x4 lo = __builtin_amdgcn_ds_read_tr16_b64_v4i16((LAS s16x4*)p_lo), hi = __builtin_amdgcn_ds_read_tr16_b64_v4i16((LAS s16x4*)p_hi);
    return (bf16x8){lo[0], lo[1], lo[2], lo[3], hi[0], hi[1], hi[2], hi[3]};
}
__device__ __forceinline__ int tr_lane_off(int lane) { return ((lane >> 4) & 1) * 32 + (lane & 3) * 8 + ((lane & 15) >> 2) * 64; }
#define MFMA32(a, b, c) __builtin_amdgcn_mfma_f32_32x32x16_bf16((a), (b), (c), 0, 0, 0)
__device__ __forceinline__ int crow(int r, int hi) { return (r & 3) + 8 * (r >> 2) + 4 * hi; }
__device__ __forceinline__ float wave_sum(float v) {
#pragma unroll
    for (int o = 1; o < 64; o <<= 1) v += __shfl_xor(v, o);
    return v;
}
#define XB_TMO      128
#define XB_XCNT(j)  (256  + 64 * (j))
#define XB_XSUB(j)  (1280 + 64 * (j))
#define XB_XGEN(j)  (2304 + 64 * (j))
#define XB_TOP      3328
#define XB_TOPGEN   3392
#define XCD_BAR_WORDS 3456
#define XB_SPIN_CAP (1u << 18)

__device__ __forceinline__ unsigned xb_ld(unsigned* p)              { return __hip_atomic_load(p, __ATOMIC_RELAXED, __HIP_MEMORY_SCOPE_AGENT); }
__device__ __forceinline__ unsigned xb_add(unsigned* p, unsigned v) { return __hip_atomic_fetch_add(p, v, __ATOMIC_RELAXED, __HIP_MEMORY_SCOPE_AGENT); }
__device__ __forceinline__ unsigned xb_xcc_id() { return (unsigned)__builtin_amdgcn_s_getreg((3 << 11) | 20) & 0xFu; }
#define XB_SPIN(cond, bar) do { unsigned _sp = 0; while (cond) { __builtin_amdgcn_s_sleep(1); \
    if ((++_sp & 255u) == 0u) { if (xb_ld(&(bar)[XB_TMO])) break; if (_sp > XB_SPIN_CAP) { atomicAdd(&(bar)[XB_TMO], 1u); break; } } } } while (0)

struct XcdBarrier {
    unsigned* bar; unsigned x;
    volatile LAS unsigned* st;
};

__device__ __forceinline__ XcdBarrier xcd_barrier_post(unsigned* bar, volatile LAS unsigned* st) {
    XcdBarrier b; b.bar = bar; b.x = xb_xcc_id(); b.st = st;
    if (threadIdx.x == 0) (void)xb_add(&bar[XB_XCNT(b.x)], 1u);
    return b;
}
__device__ __forceinline__ void xcd_barrier_complete(unsigned* bar, unsigned x, unsigned& nloc, unsigned& nx) {
    const unsigned G = gridDim.x * gridDim.y * gridDim.z;
    unsigned sum, cnt, mine, sp = 0u;
    for (;;) {
        sum = 0u; cnt = 0u; mine = 0u;
#pragma unroll
        for (unsigned j = 0; j < 16; ++j) { const unsigned c = xb_ld(&bar[XB_XCNT(j)]); sum += c; cnt += (c > 0u) ? 1u : 0u; mine = (j == x) ? c : mine; }
        if (sum == G) break;
        __builtin_amdgcn_s_sleep(1);
        if ((++sp & 255u) == 0u) { if (xb_ld(&bar[XB_TMO])) break; if (sp > XB_SPIN_CAP) { atomicAdd(&bar[XB_TMO], 1u); break; } }
    }
    nloc = mine > 0u ? mine : 1u; nx = cnt > 0u ? cnt : 1u;
}

__device__ __forceinline__ void xcd_barrier(const XcdBarrier& b) {
    asm volatile("s_waitcnt vmcnt(0)" ::: "memory");
    __syncthreads();
    if (threadIdx.x == 0) {
        unsigned* bar = b.bar;
        __builtin_amdgcn_s_waitcnt(0);
        unsigned nloc = b.st[0], nx = b.st[1];
        if (nloc == 0u) { xcd_barrier_complete(bar, b.x, nloc, nx); b.st[0] = nloc; b.st[1] = nx; }
        const unsigned old = xb_add(&bar[XB_XSUB(b.x)], 1u);
        const unsigned gen = old / nloc;
        if (old + 1u == (gen + 1u) * nloc) {
            __builtin_amdgcn_fence(__ATOMIC_RELEASE, "agent");
            asm volatile("s_waitcnt vmcnt(0)" ::: "memory");
            const unsigned og = xb_add(&bar[XB_TOP], 1u);
            const unsigned tg = og / nx;
            if (og + 1u == (tg + 1u) * nx) xb_add(&bar[XB_TOPGEN], 1u);
            else XB_SPIN(xb_ld(&bar[XB_TOPGEN]) == tg, bar);
            __builtin_amdgcn_fence(__ATOMIC_ACQUIRE, "agent");
            xb_add(&bar[XB_XGEN(b.x)], 1u);
            asm volatile("s_waitcnt vmcnt(0)" ::: "memory");
        } else {
            XB_SPIN(xb_ld(&bar[XB_XGEN(b.x)]) == gen, bar);
            __builtin_amdgcn_fence(__ATOMIC_ACQUIRE, "agent");
            asm volatile("s_waitcnt vmcnt(0)" ::: "memory");
        }
    }
    __syncthreads();
}
struct Args { const float* in[16]; float* out; unsigned char* ws; int ph_lo, ph_hi, li, pad; };
#define CAS __attribute__((address_space(4)))
struct Frame {
    const CAS Args* K;
    LAS unsigned char* lds;
    volatile LAS unsigned* MISC;
    gu32* ctl;
    int tid, lane, wave, G, bid;
};
__device__ __forceinline__ const CAS Args* KARG(const Frame& F) { const CAS Args* a = F.K; asm volatile("" : "+s"(a)); return a; }
enum { I_X = 0, I_N1G, I_WIN, I_QNG, I_KNG, I_WA2, I_BA, I_GNG, I_LNG, I_LNB, I_SGW, I_SGB, I_WOUT, I_N2G, I_W1, I_W2 };

__device__ __forceinline__ float gelu_tanh(float x) {
    const float u = 0.7978845608028654f * (x + 0.044715f * x * x * x);
    return x / (1.0f + __expf(-2.0f * u));
}
__device__ __forceinline__ float log_sigmoid(float x) { return fminf(x, 0.f) - log1pf(__expf(-fabsf(x))); }

template <int MODE>
__device__ __forceinline__ void p0_transpose_item(const float* W, int K, int Nsrc, int Ndst, const float* g, bf16* WT, LAS float* scr, int item, int lane) {
    const int nblk = Ndst / 32, kb = item / nblk, nb = item % nblk, k0 = 64 * kb, n0 = 32 * nb;
    const int nn = n0 + (lane & 31);
    int src = nn;
    if (MODE == 1) {
        const int pn = nn >> 8, ct = nn & 255, wcq = (ct >> 5) & 3, sg = 32 * (ct >> 7) + (ct & 31);
        const int dm = (pn < 3 && sg < 16) ? (4 * (sg >> 3) + (sg & 3) + 8 * ((sg >> 2) & 1)) : sg;
        const int nat = 256 * pn + 64 * wcq + dm;
        src = nat < 2304 ? nat : (nat < 2816 ? nat + 16 : (nat < 2832 ? nat - 512 : -1)); }
#pragma unroll 8
    for (int i = 0; i < 32; ++i) { const int kk = 2 * i + (lane >> 5);
        float v = 0.f; if (src >= 0) { v = W[(size_t)(k0 + kk) * Nsrc + src]; if (g) v *= g[k0 + kk]; }
        scr[kk * 33 + (lane & 31)] = v; }
    LDS_WAIT(); asm volatile("" ::: "memory");
    const int c = lane & 7;
#pragma unroll
    for (int j = 0; j < 4; ++j) { const int n = (lane >> 3) + 8 * j; const LAS float* s = scr + (8 * c) * 33 + n;
        v4u o; o.x = pk2(s[0 * 33], s[1 * 33]); o.y = pk2(s[2 * 33], s[3 * 33]); o.z = pk2(s[4 * 33], s[5 * 33]); o.w = pk2(s[6 * 33], s[7 * 33]);
        *(GAS v4u*)(WT + (size_t)(n0 + n) * K + k0 + 8 * c) = o; }
    LDS_WAIT(); asm volatile("s_waitcnt vmcnt(0)" ::: "memory");
}
__device__ __forceinline__ void p0_prologue(Frame& F) {
    LAS float* scr = (LAS float*)(F.lds + RING_OFF + F.wave * 16384);
    const int gw = F.bid * NWAVES + F.wave, NGW = F.G * NWAVES;
    constexpr int I_IN = 16 * 96, I_OUT = 16 * 32, I_1 = 16 * 128, I_2 = 64 * 32, I_L = I_IN + I_OUT + I_1 + I_2;
    for (int it = gw; it < DEPTH * I_L; it += NGW) {
        const int l = it / I_L; int r = it % I_L;
        unsigned char* wl = KARG(F)->ws + WS_W + (size_t)l * W_LAYER;
        if (r < I_IN) { p0_transpose_item<1>(KARG(F)->in[I_WIN] + (size_t)l * DMODEL * IN_DIM, DMODEL, IN_DIM, NPROJ, KARG(F)->in[I_N1G] + l * DMODEL, (bf16*)(wl + W_IN), scr, r, F.lane); continue; } r -= I_IN;
        if (r < I_OUT) { p0_transpose_item<0>(KARG(F)->in[I_WOUT] + (size_t)l * DMODEL * DMODEL, DMODEL, DMODEL, DMODEL, nullptr, (bf16*)(wl + W_OUT), scr, r, F.lane); continue; } r -= I_OUT;
        if (r < I_1) { p0_transpose_item<0>(KARG(F)->in[I_W1] + (size_t)l * DMODEL * FF, DMODEL, FF, FF, KARG(F)->in[I_N2G] + l * DMODEL, (bf16*)(wl + W_1), scr, r, F.lane); continue; } r -= I_1;
        p0_transpose_item<0>(KARG(F)->in[I_W2] + (size_t)l * FF * DMODEL, FF, DMODEL, DMODEL, nullptr, (bf16*)(wl + W_2), scr, r, F.lane);
    }
    {
        bf16* XB = (bf16*)(KARG(F)->ws + WS_XB); float* SSQ = (float*)(KARG(F)->ws + WS_SSQ);
        for (int ml = (F.bid >> 3) * NWAVES + F.wave; ml < 8192; ml += 32 * NWAVES) { const int m = (F.bid & 7) * 8192 + ml;
            const GAS f32x4* xr = (const GAS f32x4*)(KARG(F)->in[I_X] + (size_t)m * DMODEL) + F.lane;
            f32x4 v[4]; float s = 0.f;
#pragma unroll
            for (int j = 0; j < 4; ++j) { v[j] = xr[64 * j]; s += (v[j].x * v[j].x + v[j].y * v[j].y) + (v[j].z * v[j].z + v[j].w * v[j].w); }
            s = wave_sum(s);
            GAS v2u* o8 = (GAS v2u*)(XB + (size_t)m * DMODEL) + F.lane;
#pragma unroll
            for (int j = 0; j < 4; ++j) { v2u w; w.x = pk2(v[j].x, v[j].y); w.y = pk2(v[j].z, v[j].w); o8[64 * j] = w; }
            if (F.lane < 16) SSQ[(size_t)m * 16 + F.lane] = (F.lane == 0) ? s : 0.f;
            asm volatile("s_waitcnt vmcnt(0)" ::: "memory");
        }
    }
    const int gt = F.bid * (NWAVES * 64) + F.tid, NT = F.G * NWAVES * 64;
    {
        float* ROPE = (float*)(KARG(F)->ws + WS_ROPE);
        for (int idx = gt; idx < SEQ * 8; idx += NT) { const int t = idx >> 3, i = idx & 7;
            const float inv = powf(500000.0f, -(float)i * 0.125f); const float ang = (float)t * inv;
            float sn, cs; sincosf(ang, &sn, &cs); ROPE[t * 16 + i] = cs; ROPE[t * 16 + 8 + i] = sn; }
    }
    {
        bf16* WSG = (bf16*)(KARG(F)->ws + WS_WSG); const float* sw = KARG(F)->in[I_SGW];
        for (int idx = gt; idx < DEPTH * 4 * 128 * 128 / 2; idx += NT) { const int e = 2 * idx, t = (e >> 7) & 127, s = e & 127;
            const float a = (s <= t) ? sw[e] : 0.f, b = (s + 1 <= t) ? sw[e + 1] : 0.f; ((GAS unsigned*)WSG)[idx] = pk2(a, b); }
    }
}

__device__ __forceinline__ void qknorm_all(Frame& F, int l) {
    bf16* P = (bf16*)(KARG(F)->ws + WS_PROJ); const float* ROPE = (const float*)(KARG(F)->ws + WS_ROPE);
    const int gt = F.bid * (NWAVES * 64) + F.tid, NT = F.G * NWAVES * 64;
    for (int p = gt; p < M * 12; p += NT) {
        const int row = p / 12, slot = p - row * 12;
        bf16* ptr = P + (size_t)row * NPROJ + slot * 64;
        const float* g = (slot < 6 ? KARG(F)->in[I_QNG] : KARG(F)->in[I_KNG]) + l * 64;
        float x[64]; float ss = 0.f;
#pragma unroll
        for (int c = 0; c < 8; ++c) { const v4u w = *(const GAS v4u*)(ptr + 8 * c); unpack8(w, x + 8 * c); }
#pragma unroll
        for (int d = 0; d < 64; ++d) ss += x[d] * x[d];
        const float r = 1.0f / sqrtf(ss * (1.0f / 64.0f) + EPS);
#pragma unroll
        for (int c = 0; c < 16; ++c) { const f32x4 gv = *(const f32x4*)(g + 4 * c); x[4 * c] *= r * gv[0]; x[4 * c + 1] *= r * gv[1]; x[4 * c + 2] *= r * gv[2]; x[4 * c + 3] *= r * gv[3]; }
        const int t = row & (SEQ - 1);
        const f32x4 c0 = *(const f32x4*)(ROPE + t * 16), c1 = *(const f32x4*)(ROPE + t * 16 + 4), s0 = *(const f32x4*)(ROPE + t * 16 + 8), s1 = *(const f32x4*)(ROPE + t * 16 + 12);
#pragma unroll
        for (int i = 0; i < 8; ++i) { const float cs = i < 4 ? c0[i & 3] : c1[i & 3], sn = i < 4 ? s0[i & 3] : s1[i & 3]; const float a = x[i], b = x[i + 8]; x[i] = a * cs - b * sn; x[i + 8] = b * cs + a * sn; }
        const float sc = slot < 6 ? 0.125f : 1.0f;
#pragma unroll
        for (int c = 0; c < 8; ++c) { v4u w; w.x = pk2(x[8 * c] * sc, x[8 * c + 1] * sc); w.y = pk2(x[8 * c + 2] * sc, x[8 * c + 3] * sc); w.z = pk2(x[8 * c + 4] * sc, x[8 * c + 5] * sc); w.w = pk2(x[8 * c + 6] * sc, x[8 * c + 7] * sc);
            *(GAS v4u*)(ptr + 8 * c) = w; }
    }
}
__device__ __forceinline__ void stage_v64(const bf16* src, LAS unsigned char* vl, int lane) {
#pragma unroll
    for (int c = 0; c < 8; ++c) { const int idx = 64 * c + lane, db = idx >> 8, row = (idx >> 2) & 63, c4 = idx & 3;
        const v4u w = *(const GAS v4u*)(src + (size_t)row * NPROJ + db * 32 + c4 * 8); *(LAS v4u*)(vl + idx * 16) = w; }
}
__device__ __forceinline__ void gla_g1_unit(Frame& F, int l, int bh, int grp) {
    int tid = F.tid; asm volatile("" : "+v"(tid));
    const int lane = tid & 63, wave = F.wave, i = lane & 31, hh = lane >> 5;
    const int b = bh / 6, h = bh - b * 6, n = grp * 8 + wave;
    const bf16* P = (const bf16*)(KARG(F)->ws + WS_PROJ) + ((size_t)b * SEQ + n * 64) * NPROJ;
    LAS unsigned char* wl = F.lds + RING_OFF + wave * 16384;
    LAS unsigned char* vl = wl; LAS unsigned char* kl = wl + 8192;
    stage_v64(P + VG + h * 64, vl, lane);
#pragma unroll
    for (int c = 0; c < 4; ++c) { const int idx = 64 * c + lane, row = idx >> 2, c4 = idx & 3;
        const v4u w = *(const GAS v4u*)(P + (size_t)row * NPROJ + KG + h * 32 + c4 * 8); *(LAS v4u*)(kl + idx * 16) = w; }
    bf16x8 wfrag;
    { const float* wa2 = KARG(F)->in[I_WA2] + (size_t)l * 16 * 192 + (8 * hh) * 192 + h * 32 + i;
      v4u w; w.x = pk2(wa2[0], wa2[192]); w.y = pk2(wa2[2 * 192], wa2[3 * 192]); w.z = pk2(wa2[4 * 192], wa2[5 * 192]); w.w = pk2(wa2[6 * 192], wa2[7 * 192]); wfrag = as_frag(w); }
    const float bias = KARG(F)->in[I_BA][l * 192 + h * 32 + i];
    float bc[2][16]; float carry = 0.f;
#pragma unroll
    for (int T = 0; T < 2; ++T) {
        const bf16x8 afrag = as_frag(*(const GAS v4u*)(P + (size_t)(32 * T + i) * NPROJ + AG + 8 * hh));
        f32x16 D = {}; D = MFMA32(afrag, wfrag, D);
        float tb[4];
#pragma unroll
        for (int q = 0; q < 4; ++q) { float run = 0.f;
#pragma unroll
            for (int e = 0; e < 4; ++e) { const float x = D[4 * q + e] + bias; run += (fminf(x, 0.f) - __logf(1.0f + __expf(-fabsf(x)))) * (1.0f / 16.0f); bc[T][4 * q + e] = run; }
            tb[q] = run; }
        float off = carry;
#pragma unroll
        for (int q = 0; q < 4; ++q) { const float ob = __shfl_xor(tb[q], 32); const float o = off + (hh ? ob : 0.f);
#pragma unroll
            for (int e = 0; e < 4; ++e) bc[T][4 * q + e] += o;
            off += tb[q] + ob; }
        carry = off;
    }
    const float blast = carry;
    const size_t cidx = (size_t)bh * 32 + n;
    { float* BC = (float*)(KARG(F)->ws + WS_BC) + cidx * 2048;
#pragma unroll
      for (int T = 0; T < 2; ++T)
#pragma unroll
        for (int r = 0; r < 16; ++r) BC[(32 * T + crow(r, hh)) * 32 + i] = bc[T][r]; asm volatile("s_waitcnt vmcnt(0)" ::: "memory"); }
    f32x16 kv0 = {}, kv1 = {};
    const int tro = tr_lane_off(lane);
#pragma unroll
    for (int s = 0; s < 4; ++s) { const int T = s >> 1, rb = 8 * (s & 1); float ke[8];
#pragma unroll
        for (int e = 0; e < 8; ++e) { const int t = 32 * T + crow(rb + e, hh); ke[e] = bf1(*(const LAS unsigned short*)(kl + t * 64 + i * 2)) * __expf(blast - bc[T][rb + e]); }
        v4u w; w.x = pk2(ke[0], ke[1]); w.y = pk2(ke[2], ke[3]); w.z = pk2(ke[4], ke[5]); w.w = pk2(ke[6], ke[7]);
        const bf16x8 af = as_frag(w); const int t0 = 32 * T + 16 * (s & 1) + 4 * hh;
        const bf16x8 v0 = tr_frag(vl + t0 * 64 + tro, vl + (t0 + 8) * 64 + tro);
        const bf16x8 v1 = tr_frag(vl + 4096 + t0 * 64 + tro, vl + 4096 + (t0 + 8) * 64 + tro);
        kv0 = MFMA32(af, v0, kv0); kv1 = MFMA32(af, v1, kv1); }
    { LAS float* kvl = (LAS float*)vl;
#pragma unroll
      for (int r = 0; r < 16; ++r) { kvl[crow(r, hh) * 64 + i] = kv0[r]; kvl[crow(r, hh) * 64 + 32 + i] = kv1[r]; }
      if (hh == 0) ((LAS float*)kl)[i] = __expf(blast); }
    __syncthreads();
    {
        const int e0 = tid * 4, si = e0 >> 6;
        float* KV = (float*)(KARG(F)->ws + WS_KVS) + ((size_t)bh * 32 + grp * 8) * 2048 + e0;
        f32x4 agg = {0.f, 0.f, 0.f, 0.f}; float dprod = 1.f;
#pragma unroll
        for (int k = 0; k < 8; ++k) { const LAS unsigned char* wk = F.lds + RING_OFF + k * 16384;
            const f32x4 kvk = *(const LAS f32x4*)(wk + e0 * 4); const float dk = *(const LAS float*)(wk + 8192 + si * 4);
            *(GAS f32x4*)(KV + (size_t)k * 2048) = kvk; agg = agg * dk + kvk; dprod *= dk;
            if ((tid & 15) == 0) ((float*)(KARG(F)->ws + WS_DEC + l * DEC_STRIDE))[((size_t)bh * 32 + grp * 8 + k) * 32 + si] = dk; }
        *(GAS f32x4*)((float*)(KARG(F)->ws + WS_AGS + l * AGS_STRIDE) + ((size_t)bh * 4 + grp) * 2048 + e0) = agg;
        if ((tid & 15) == 0) ((float*)(KARG(F)->ws + WS_AGD + l * AGD_STRIDE))[((size_t)bh * 4 + grp) * 32 + si] = dprod;
        asm volatile("s_waitcnt vmcnt(0)" ::: "memory");
    }
    __syncthreads();
}
__device__ __forceinline__ void sg_unit(Frame& F, int l, int b, int n) {
    int lane = F.lane; asm volatile("" : "+v"(lane));
    const int wave = F.wave, c31 = lane & 31, hh = lane >> 5;
    const bf16* P = (const bf16*)(KARG(F)->ws + WS_PROJ) + ((size_t)b * SEQ + n * 128) * NPROJ;
    bf16* MIX = (bf16*)(KARG(F)->ws + WS_MIX) + ((size_t)b * SEQ + n * 128) * DMODEL;
    LAS unsigned char* VV = F.lds + RING_OFF;
    {
        float g8[8], b8[8];
        { const float* lg = KARG(F)->in[I_LNG] + l * 256 + 8 * c31; const float* lb = KARG(F)->in[I_LNB] + l * 256 + 8 * c31;
#pragma unroll
          for (int e = 0; e < 8; ++e) { g8[e] = lg[e]; b8[e] = lb[e]; } }
#pragma unroll 2
        for (int it = 0; it < 8; ++it) { const int s = 16 * wave + 2 * it + hh;
            const v4u w = *(const GAS v4u*)(P + (size_t)s * NPROJ + ZS + 256 + 8 * c31);
            float x[8]; unpack8(w, x); float sum = 0.f;
#pragma unroll
            for (int e = 0; e < 8; ++e) { x[e] = gelu_tanh(x[e]); sum += x[e]; }
#pragma unroll
            for (int o = 1; o < 32; o <<= 1) sum += __shfl_xor(sum, o);
            const float mean = sum * (1.0f / 256.0f); float sq = 0.f;
#pragma unroll
            for (int e = 0; e < 8; ++e) { x[e] -= mean; sq += x[e] * x[e]; }
#pragma unroll
            for (int o = 1; o < 32; o <<= 1) sq += __shfl_xor(sq, o);
            const float rstd = 1.0f / sqrtf(sq * (1.0f / 256.0f) + EPS);
#pragma unroll
            for (int e = 0; e < 8; ++e) x[e] = x[e] * rstd * g8[e] + b8[e];
            v4u o; o.x = pk2(x[0], x[1]); o.y = pk2(x[2], x[3]); o.z = pk2(x[4], x[5]); o.w = pk2(x[6], x[7]);
            *(LAS v4u*)(VV + (c31 >> 3) * 16384 + ((c31 >> 2) & 1) * 8192 + s * 64 + (c31 & 3) * 16) = o; }
    }
    __syncthreads();
    {
        const int g = wave >> 1; const int tro = tr_lane_off(lane);
        const bf16* WSG = (const bf16*)(KARG(F)->ws + WS_WSG) + (size_t)(l * 4 + g) * 128 * 128;
        const LAS unsigned char* vg = VV + g * 16384;
#pragma unroll 1
        for (int q = 0; q < 2; ++q) { const int tb = (wave & 1) ? (1 + q) : (3 * q); const int t = 32 * tb + c31;
            f32x16 D0 = {}, D1 = {};
#pragma unroll 1
            for (int sb = 0; sb <= tb; ++sb) {
#pragma unroll
                for (int ks = 0; ks < 2; ++ks) { const int s0 = 32 * sb + 16 * ks + 8 * hh;
                    const bf16x8 wf = as_frag(*(const GAS v4u*)(WSG + (size_t)t * 128 + s0));
                    const bf16x8 v0 = tr_frag(vg + s0 * 64 + tro, vg + (s0 + 4) * 64 + tro);
                    const bf16x8 v1 = tr_frag(vg + 8192 + s0 * 64 + tro, vg + 8192 + (s0 + 4) * 64 + tro);
                    D0 = MFMA32(v0, wf, D0); D1 = MFMA32(v1, wf, D1); } }
            const float bias = KARG(F)->in[I_SGB][(l * 4 + g) * 128 + t];
#pragma unroll
            for (int cb = 0; cb < 2; ++cb)
#pragma unroll
                for (int g4 = 0; g4 < 4; ++g4) { const int c0 = 32 * cb + 8 * g4 + 4 * hh;
                    const v2u uw = *(const GAS v2u*)(P + (size_t)t * NPROJ + ZS + 64 * g + c0);
                    const float u0 = gelu_tanh(bflo(uw.x)), u1 = gelu_tanh(bfhi(uw.x)), u2 = gelu_tanh(bflo(uw.y)), u3 = gelu_tanh(bfhi(uw.y));
                    const float d0 = cb ? D1[4 * g4] : D0[4 * g4], d1 = cb ? D1[4 * g4 + 1] : D0[4 * g4 + 1], d2 = cb ? D1[4 * g4 + 2] : D0[4 * g4 + 2], d3 = cb ? D1[4 * g4 + 3] : D0[4 * g4 + 3];
                    v2u o; o.x = pk2(u0 * (d0 + bias), u1 * (d1 + bias)); o.y = pk2(u2 * (d2 + bias), u3 * (d3 + bias));
                    *(GAS v2u*)(MIX + (size_t)t * DMODEL + 768 + 64 * g + c0) = o; }
            asm volatile("s_waitcnt vmcnt(0)" ::: "memory");
        }
    }
    __syncthreads();
}
__device__ __forceinline__ void gla_g2_unit(Frame& F, int l, int bh, int grp) {
    int tid = F.tid; asm volatile("" : "+v"(tid));
    const int lane = tid & 63, wave = F.wave, c31 = lane & 31, hh = lane >> 5;
    const int b = bh / 6, h = bh - b * 6;
    LAS unsigned char* ST = F.lds + RING_OFF;
    LAS unsigned char* vl = F.lds + RING_OFF + 32768 + wave * 8192;
    const int n0 = grp * 8;
    {
        const int e0 = tid * 4, si = e0 >> 6, sj = e0 & 63;
        const float* KV = (const float*)(KARG(F)->ws + WS_KVS) + (size_t)bh * 32 * 2048 + e0;
        const float* DEC = (const float*)(KARG(F)->ws + WS_DEC + l * DEC_STRIDE) + (size_t)bh * 32 * 32 + si;
        const float* AGS = (const float*)(KARG(F)->ws + WS_AGS + l * AGS_STRIDE) + (size_t)bh * 4 * 2048 + e0;
        const float* AGD = (const float*)(KARG(F)->ws + WS_AGD + l * AGD_STRIDE) + (size_t)bh * 4 * 32 + si;
        f32x4 ag[3]; float ad[3]; f32x4 kvm[7]; float dm[7];
#pragma unroll
        for (int g = 0; g < 3; ++g) { const int gg = g < grp ? g : 0; ag[g] = *(const GAS f32x4*)(AGS + (size_t)gg * 2048); ad[g] = AGD[gg * 32]; }
#pragma unroll
        for (int k = 0; k < 7; ++k) { kvm[k] = *(const GAS f32x4*)(KV + (size_t)(n0 + k) * 2048); dm[k] = DEC[(n0 + k) * 32]; }
        f32x4 st = {0.f, 0.f, 0.f, 0.f};
#pragma unroll
        for (int g = 0; g < 3; ++g) if (g < grp) st = st * ad[g] + ag[g];
        LAS unsigned char* sp = ST + (sj >> 5) * 2048 + si * 64 + (sj & 31) * 2;
#pragma unroll
        for (int k = 0; k < 8; ++k) {
            v2u w; w.x = pk2(st[0], st[1]); w.y = pk2(st[2], st[3]); *(LAS v2u*)(sp + k * 4096) = w;
            if (k < 7) st = st * dm[k] + kvm[k];
        }
    }
    __syncthreads();
    {
        const int n = n0 + wave;
        const size_t tok0 = (size_t)b * SEQ + n * 64;
        const bf16* P = (const bf16*)(KARG(F)->ws + WS_PROJ) + tok0 * NPROJ;
        bf16* MIX = (bf16*)(KARG(F)->ws + WS_MIX) + tok0 * DMODEL;
        const float* BC = (const float*)(KARG(F)->ws + WS_BC) + ((size_t)bh * 32 + n) * 2048;
        stage_v64(P + VG + h * 64, vl, lane);
        bf16x8 qf[2][2], kf[2][2];
#pragma unroll
        for (int tb = 0; tb < 2; ++tb)
#pragma unroll
            for (int s = 0; s < 2; ++s) { const int t = 32 * tb + c31, i0 = 16 * s + 8 * hh;
                const v4u qw = *(const GAS v4u*)(P + (size_t)t * NPROJ + QG + h * 32 + i0), kw = *(const GAS v4u*)(P + (size_t)t * NPROJ + KG + h * 32 + i0);
                const f32x4 b0 = *(const GAS f32x4*)(BC + t * 32 + i0), b1 = *(const GAS f32x4*)(BC + t * 32 + i0 + 4);
                float q[8], k[8]; unpack8(qw, q); unpack8(kw, k);
#pragma unroll
                for (int e = 0; e < 8; ++e) { const float bb = e < 4 ? b0[e & 3] : b1[e & 3]; q[e] *= 0.17677669529663687f * __expf(bb); k[e] *= __expf(-bb); }
                v4u w; w.x = pk2(q[0], q[1]); w.y = pk2(q[2], q[3]); w.z = pk2(q[4], q[5]); w.w = pk2(q[6], q[7]); qf[tb][s] = as_frag(w);
                w.x = pk2(k[0], k[1]); w.y = pk2(k[2], k[3]); w.z = pk2(k[4], k[5]); w.w = pk2(k[6], k[7]); kf[tb][s] = as_frag(w); }
        const int tro = tr_lane_off(lane);
        f32x16 OT[2][2];
#pragma unroll
        for (int jb = 0; jb < 2; ++jb)
#pragma unroll
            for (int tb = 0; tb < 2; ++tb) OT[jb][tb] = (f32x16){};
        const LAS unsigned char* stw = ST + wave * 4096;
#pragma unroll
        for (int jb = 0; jb < 2; ++jb)
#pragma unroll
            for (int s = 0; s < 2; ++s) { const int r0 = 16 * s + 8 * hh;
                const bf16x8 sf = tr_frag(stw + jb * 2048 + r0 * 64 + tro, stw + jb * 2048 + (r0 + 4) * 64 + tro);
#pragma unroll
                for (int tb = 0; tb < 2; ++tb) OT[jb][tb] = MFMA32(sf, qf[tb][s], OT[jb][tb]); }
#pragma unroll
        for (int xt = 0; xt < 3; ++xt) { const int sb = xt >> 1, tb = (xt + 1) >> 1;
            f32x16 X = {};
#pragma unroll
            for (int s = 0; s < 2; ++s) X = MFMA32(kf[sb][s], qf[tb][s], X);
            if (sb == tb) {
#pragma unroll
                for (int r = 0; r < 16; ++r) if (crow(r, hh) > c31) X[r] = 0.f; }
#pragma unroll
            for (int s2 = 0; s2 < 2; ++s2) {
                v4u w; w.x = pk2(X[8 * s2], X[8 * s2 + 1]); w.y = pk2(X[8 * s2 + 2], X[8 * s2 + 3]); w.z = pk2(X[8 * s2 + 4], X[8 * s2 + 5]); w.w = pk2(X[8 * s2 + 6], X[8 * s2 + 7]);
                const bf16x8 xf = as_frag(w); const int r0 = 32 * sb + 16 * s2 + 4 * hh;
#pragma unroll
                for (int jb = 0; jb < 2; ++jb) { const bf16x8 vf = tr_frag(vl + jb * 4096 + r0 * 64 + tro, vl + jb * 4096 + (r0 + 8) * 64 + tro);
                    OT[jb][tb] = MFMA32(vf, xf, OT[jb][tb]); } } }
        const float* gn = KARG(F)->in[I_GNG] + l * 64;
#pragma unroll
        for (int tb = 0; tb < 2; ++tb) { const int t = 32 * tb + c31; float ss = 0.f;
#pragma unroll
            for (int jb = 0; jb < 2; ++jb)
#pragma unroll
                for (int r = 0; r < 16; ++r) ss += OT[jb][tb][r] * OT[jb][tb][r];
            ss += __shfl_xor(ss, 32);
            const float rstd = 1.0f / sqrtf(ss * (1.0f / 64.0f) + EPS);
#pragma unroll
            for (int jb = 0; jb < 2; ++jb)
#pragma unroll
                for (int g4 = 0; g4 < 4; ++g4) { const int j0 = 32 * jb + 8 * g4 + 4 * hh;
                    const v2u rw = *(const GAS v2u*)(P + (size_t)t * NPROJ + RG + h * 64 + j0); const f32x4 gv = *(const f32x4*)(gn + j0);
                    float rr[4] = {bflo(rw.x), bfhi(rw.x), bflo(rw.y), bfhi(rw.y)}; float y[4];
#pragma unroll
                    for (int e = 0; e < 4; ++e) { const float sl = rr[e] / (1.0f + __expf(-rr[e])); y[e] = OT[jb][tb][4 * g4 + e] * rstd * gv[e] * sl; }
                    v2u o; o.x = pk2(y[0], y[1]); o.y = pk2(y[2], y[3]);
                    *(GAS v2u*)(MIX + (size_t)t * DMODEL + 384 + h * 64 + j0) = o; } asm volatile("s_waitcnt vmcnt(0)" ::: "memory"); }
    }
    __syncthreads();
}
constexpr int ATT_KPITCH = 144, ATT_NKEYS = 384, ATT_VOFF = ATT_NKEYS * ATT_KPITCH  , ATT_VDB = ATT_NKEYS * 64  ;
constexpr int ATT_UNITS = 3 * 1536, ATT_PER_WG = ATT_UNITS / 256;
struct AttUnit { int r, bh, d, rho, I0, sub; };
__device__ __forceinline__ AttUnit att_decode(int bid, int k) {
    const int xl = bid & 7, rk = bid >> 3; AttUnit a; a.r = k / 6; const int v = rk + 32 * (k - 6 * a.r);
    a.bh = 24 * xl + (v >> 3); a.sub = ((v & 7) + k) & 7;
    if (a.r == 0) { a.d = 1; a.rho = 0; a.I0 = 256 * a.sub; } else if (a.r == 1) { a.d = 4; a.rho = a.sub >> 1; a.I0 = 256 * (a.sub & 1); } else { a.d = 16; a.rho = 2 * a.sub; a.I0 = 0; }
    return a;
}
#define ATT_STAGE_LOAD(U, ST) do { const int b_ = (U).bh / 6, h_ = (U).bh - b_ * 6; \
    const bf16* src_ = Pall + (size_t)b_ * SEQ * NPROJ + (skv ? VA : KA) + h_ * 64 + sc8 * 8; \
    _Pragma("unroll") for (int s_ = 0; s_ < 12; ++s_) { \
        int rho_ = (U).rho, ikb_ = (U).I0 - 128 + 32 * s_; if ((U).r == 2) { rho_ += (s_ >> 2) & 1; ikb_ = 32 * (s_ & 3); } \
        ikb_ = ikb_ < 0 ? 0 : ikb_;     \
        ST[s_] = *(const GAS v4u*)(src_ + (size_t)(rho_ + (U).d * (ikb_ + skk)) * NPROJ); } } while (0)
#define ATT_STAGE_WRITE(U, ST) do { \
    _Pragma("unroll") for (int s_ = 0; s_ < 12; ++s_) *(LAS v4u*)(sdst + s_ * (skv ? 32 * 64 : 32 * ATT_KPITCH)) = ST[s_]; } while (0)
#define ATT_Q_LOAD(U, QF) do { const int b_ = (U).bh / 6, h_ = (U).bh - b_ * 6; \
    const int rho_ = (U).rho + ((U).r == 2 ? (wave >> 2) : 0), i0_ = (U).I0 + 32 * ((U).r == 2 ? (wave & 3) : wave); \
    const bf16* qp_ = Pall + ((size_t)b_ * SEQ + rho_ + (U).d * (i0_ + j)) * NPROJ + QA + h_ * 64 + 8 * hh; \
    _Pragma("unroll") for (int s_ = 0; s_ < 4; ++s_) QF[s_] = *(const GAS v4u*)(qp_ + 16 * s_); } while (0)
__device__ __forceinline__ void att_phase(Frame& F, int l) {
    int tid = F.tid; asm volatile("" : "+v"(tid));
    const int lane = tid & 63, wave = F.wave, j = lane & 31, hh = lane >> 5;
    const bf16* Pall = (const bf16*)(KARG(F)->ws + WS_PROJ);
    bf16* OR = l == 0 ? (bf16*)(KARG(F)->ws + WS_OR) : (bf16*)KARG(F)->out; float* LSE = (float*)(KARG(F)->ws + WS_LSE + l * LSE_STRIDE);
    LAS unsigned char* Kimg = F.lds + RING_OFF; LAS unsigned char* Vimg = F.lds + RING_OFF + ATT_VOFF;
    const int skv = tid >> 8, skk = (tid & 255) >> 3, sc8 = tid & 7;
    LAS unsigned char* sdst = skv ? (Vimg + (sc8 >> 2) * ATT_VDB + skk * 64 + (sc8 & 3) * 16) : (Kimg + skk * ATT_KPITCH + sc8 * 16);
    const int tro = tr_lane_off(lane);
    v4u st[12], qn[4];
    int bidq = F.bid; asm volatile("" : "+s"(bidq));
    AttUnit cur = att_decode(bidq, 0);
    ATT_STAGE_LOAD(cur, st); ATT_Q_LOAD(cur, qn);
#pragma unroll 1
    for (int k = 0; k < ATT_PER_WG; ++k) {
        asm volatile("s_waitcnt vmcnt(0)" : "+v"(st[0]), "+v"(st[1]), "+v"(st[2]), "+v"(st[3]), "+v"(st[4]), "+v"(st[5]), "+v"(st[6]), "+v"(st[7]), "+v"(st[8]), "+v"(st[9]), "+v"(st[10]), "+v"(st[11]),
                     "+v"(qn[0]), "+v"(qn[1]), "+v"(qn[2]), "+v"(qn[3]) :: "memory");
        ATT_STAGE_WRITE(cur, st);
        bf16x8 qf[4];
#pragma unroll
        for (int s = 0; s < 4; ++s) qf[s] = as_frag(qn[s]);
        const AttUnit nxt = att_decode(bidq, (k + 1 < ATT_PER_WG) ? k + 1 : k);
        if (k + 1 < ATT_PER_WG) { ATT_STAGE_LOAD(nxt, st); ATT_Q_LOAD(nxt, qn); }
        __syncthreads();
        {
            const int b = cur.bh / 6, h = cur.bh - b * 6;
            const int wq = (cur.r == 2) ? (wave & 3) : wave;
            const int i0 = cur.I0 + 32 * wq, rho = cur.rho + ((cur.r == 2) ? (wave >> 2) : 0);
            const int slot0 = (cur.r == 2) ? ((wave >> 2) * 4 + wq - 4) : wq;
            int kt = (i0 >= 128) ? 0 : ((128 - i0) >> 5);
            f32x16 O0 = {}, O1 = {}; float m = -1e30f, lsum = 0.f;
            bf16x8 kf[4];
            { const LAS unsigned char* kp = Kimg + ((slot0 + kt) * 32 + j) * ATT_KPITCH + hh * 16;
#pragma unroll
              for (int s = 0; s < 4; ++s) kf[s] = *(const LAS bf16x8*)(kp + 32 * s); }
#pragma unroll 1
            for (; kt < 5; ++kt) {
                f32x16 S = {};
#pragma unroll
                for (int s = 0; s < 4; ++s) S = MFMA32(kf[s], qf[s], S);
                const int ktn = kt < 4 ? kt + 1 : kt;
                { const LAS unsigned char* kp = Kimg + ((slot0 + ktn) * 32 + j) * ATT_KPITCH + hh * 16;
#pragma unroll
                  for (int s = 0; s < 4; ++s) kf[s] = *(const LAS bf16x8*)(kp + 32 * s); }
                if (kt == 0) {
#pragma unroll
                    for (int r = 0; r < 16; ++r) if (crow(r, hh) < j) S[r] = -1e30f; }
                if (kt == 4) {
#pragma unroll
                    for (int r = 0; r < 16; ++r) if (crow(r, hh) > j) S[r] = -1e30f; }
                float mt = S[0];
#pragma unroll
                for (int r = 1; r < 16; ++r) mt = fmaxf(mt, S[r]);
                mt = fmaxf(mt, __shfl_xor(mt, 32));
                const float mn = fmaxf(m, mt), alpha = __expf(m - mn); m = mn;
                float ps = 0.f;
#pragma unroll
                for (int r = 0; r < 16; ++r) { S[r] = __expf(S[r] - mn); ps += S[r]; }
                lsum = lsum * alpha + ps;
#pragma unroll
                for (int r = 0; r < 16; ++r) { O0[r] *= alpha; O1[r] *= alpha; }
                const LAS unsigned char* vb = Vimg + (slot0 + kt) * 32 * 64 + tro;
#pragma unroll
                for (int s2 = 0; s2 < 2; ++s2) {
                    v4u w; w.x = pk2(S[8 * s2], S[8 * s2 + 1]); w.y = pk2(S[8 * s2 + 2], S[8 * s2 + 3]); w.z = pk2(S[8 * s2 + 4], S[8 * s2 + 5]); w.w = pk2(S[8 * s2 + 6], S[8 * s2 + 7]);
                    const bf16x8 pf = as_frag(w); const int r0 = 16 * s2 + 4 * hh;
                    const bf16x8 v0 = tr_frag(vb + r0 * 64, vb + (r0 + 8) * 64);
                    const bf16x8 v1 = tr_frag(vb + ATT_VDB + r0 * 64, vb + ATT_VDB + (r0 + 8) * 64);
                    O0 = MFMA32(v0, pf, O0); O1 = MFMA32(v1, pf, O1); }
            }
            const float ltot = lsum + __shfl_xor(lsum, 32), inv = 1.0f / ltot, lse = m + __logf(ltot);
            const size_t tok = (size_t)cur.r * M + (size_t)b * SEQ + rho + cur.d * (i0 + j);
            bf16* rp = OR + tok * 384 + h * 64;
#pragma unroll
            for (int g4 = 0; g4 < 4; ++g4) { const int d0 = 8 * g4 + 4 * hh;
                v2u w; w.x = pk2(O0[4 * g4] * inv, O0[4 * g4 + 1] * inv); w.y = pk2(O0[4 * g4 + 2] * inv, O0[4 * g4 + 3] * inv); *(GAS v2u*)(rp + d0) = w;
                w.x = pk2(O1[4 * g4] * inv, O1[4 * g4 + 1] * inv); w.y = pk2(O1[4 * g4 + 2] * inv, O1[4 * g4 + 3] * inv); *(GAS v2u*)(rp + 32 + d0) = w; }
            if (hh == 0) LSE[((size_t)cur.r * 192 + cur.bh) * 2048 + rho * (2048 / cur.d) + i0 + j] = lse;
        }
        __syncthreads();
        cur = nxt;
    }
}
#undef ATT_STAGE_LOAD
#undef ATT_STAGE_WRITE
#undef ATT_Q_LOAD
__device__ __forceinline__ void att_combine(Frame& F, int l) {
    const bf16* OR = l == 0 ? (const bf16*)(KARG(F)->ws + WS_OR) : (const bf16*)KARG(F)->out; const float* LSE = (const float*)(KARG(F)->ws + WS_LSE + l * LSE_STRIDE);
    bf16* MIX = (bf16*)(KARG(F)->ws + WS_MIX);
    int tq = F.tid; asm volatile("" : "+v"(tq));
    const int gt = (F.bid >> 3) * (NWAVES * 64) + tq, tokx = (F.bid & 7) * 8192;
    constexpr int NT = 32 * NWAVES * 64;
#pragma unroll 1
    for (int g = gt; g < 8192 * 48; g += NT) { const int tl = g / 48, pc = g - tl * 48, hd = pc >> 3, tok = tokx + tl;
        const int bq_ = tok >> 11, p_ = tok & 2047; const size_t lb = (size_t)(bq_ * 6 + hd) * 2048;
        const float l0 = LSE[lb + p_], l1 = LSE[(size_t)192 * 2048 + lb + (p_ & 3) * 512 + (p_ >> 2)], l2 = LSE[(size_t)384 * 2048 + lb + (p_ & 15) * 128 + (p_ >> 4)];
        const v4u a = *(const GAS v4u*)(OR + (size_t)tok * 384 + pc * 8), bq = *(const GAS v4u*)(OR + ((size_t)M + tok) * 384 + pc * 8), cq = *(const GAS v4u*)(OR + ((size_t)2 * M + tok) * 384 + pc * 8);
        const float mx = fmaxf(l0, fmaxf(l1, l2)); float w0 = __expf(l0 - mx), w1 = __expf(l1 - mx), w2 = __expf(l2 - mx);
        const float wi = 1.0f / (w0 + w1 + w2); w0 *= wi; w1 *= wi; w2 *= wi;
        float fa[8], fb[8], fc[8]; unpack8(a, fa); unpack8(bq, fb); unpack8(cq, fc);
        float o[8];
#pragma unroll
        for (int e = 0; e < 8; ++e) o[e] = w0 * fa[e] + w1 * fb[e] + w2 * fc[e];
        v4u w; w.x = pk2(o[0], o[1]); w.y = pk2(o[2], o[3]); w.z = pk2(o[4], o[5]); w.w = pk2(o[6], o[7]);
        *(GAS v4u*)(MIX + (size_t)tok * DMODEL + pc * 8) = w; asm volatile("s_waitcnt vmcnt(0)" ::: "memory"); }
}
__global__ void __launch_bounds__(NWAVES * 64, 2) hybrid_fwd(const Args args) {
    extern __shared__ __attribute__((aligned(16))) unsigned char lds[];
    Frame F;
    F.lds = (LAS unsigned char*)lds;
    F.MISC = (volatile LAS unsigned*)(F.lds + MISC_OFF);
    F.tid = threadIdx.x; F.lane = F.tid & 63; F.wave = __builtin_amdgcn_readfirstlane(F.tid >> 6);
    F.G = gridDim.x; F.bid = blockIdx.x;
    F.K = (const CAS Args*)__builtin_amdgcn_kernarg_segment_ptr(); F.ctl = (gu32*)(args.ws + WS_CTL);
    for (int u = F.tid; u < LDS_BYTES / 4; u += NWAVES * 64) ((LAS unsigned*)(F.lds))[u] = 0u;
    __syncthreads();
    XcdBarrier bar; bar.bar = (unsigned*)(F.ctl + CW_BAR) + args.li * XCD_BAR_WORDS; bar.x = 0; bar.st = nullptr;
    if (true) bar = xcd_barrier_post((unsigned*)(F.ctl + CW_BAR) + args.li * XCD_BAR_WORDS, F.MISC + 8);
    const int lo = args.ph_lo, hi = args.ph_hi;
#ifndef REP_P0
#define REP_P0 1
#endif
#ifndef DRY35
#define DRY35 0
#endif
#ifndef REP_P1
#define REP_P1 1
#endif
#ifndef REP_P4
#define REP_P4 1
#endif
#ifndef REP_ATT
#define REP_ATT 1
#endif
#ifndef REP_G2
#define REP_G2 1
#endif
#ifndef REP_G1
#define REP_G1 1
#endif
#ifndef REP_SG
#define REP_SG 1
#endif
#define REPLOOP(N) _Pragma("unroll 1") for (int rep_ = 0, reps_ = __builtin_amdgcn_readfirstlane(N); rep_ < reps_; ++rep_)
#ifndef PH_MASK
#define PH_MASK 127
#endif
#define HASP(j) (((PH_MASK) >> (j)) & 1)
#define IN(k) (lo <= (k) && (k) < hi)
#define SEAM(k) do { if (IN(k) && IN((k) + 1)) xcd_barrier(bar); } while (0)

    if (HASP(0) && IN(0)) { REPLOOP(REP_P0) { p0_prologue(F); __syncthreads(); } SEAM(0); }

    bf16* XB = (bf16*)(KARG(F)->ws + WS_XB);
    bf16* PROJ = (bf16*)(KARG(F)->ws + WS_PROJ); bf16* MIXB = (bf16*)(KARG(F)->ws + WS_MIX); bf16* HID = (bf16*)(KARG(F)->ws + WS_HID);
#pragma unroll
    for (int l = 0; l < DEPTH; ++l) {
        const int pb = 1 + 6 * l;
        unsigned char* wl = KARG(F)->ws + WS_W + (size_t)l * W_LAYER;
        if (HASP(1) && IN(pb)) {
            pg8::Gemm g{XB, (const bf16*)(wl + W_IN), M, NPROJ, DMODEL}; pg8::StaticOrder S; S.init(M, NPROJ, F.G, F.bid);
            pg8::EpiProj E{PROJ, NPROJ, (const float*)(KARG(F)->ws + WS_SSQ + (size_t)(2 * l) * SSQ_STRIDE), KARG(F)->in[I_QNG] + l * 64, KARG(F)->in[I_KNG] + l * 64, (const float*)(KARG(F)->ws + WS_ROPE), 1.0f / DMODEL, EPS};
            REPLOOP(REP_P1) pg8::gemm_phase<pg8::EpiProj, pg8::StaticOrder, true, true>(F.lds + RING_OFF, g, S, E);
            SEAM(pb);
        }
        if (HASP(2) && IN(pb + 1)) {
            REPLOOP(REP_G1) {
#pragma unroll 1
            for (int k = 0; k < 3; ++k) { const int u = (F.bid >> 3) + 32 * k;
            if (u < 96) gla_g1_unit(F, l, 24 * (F.bid & 7) + (u >> 2), u & 3);
            } }
            __syncthreads();
            REPLOOP(REP_SG) {
#pragma unroll 1
            for (int k = 0; k < 2; ++k) { const int u = (F.bid >> 3) + 32 * k;
            if (u < 64) sg_unit(F, l, 4 * (F.bid & 7) + (u >> 4), u & 15);
            } }
            REPLOOP(REP_ATT) { att_phase(F, l); }
            SEAM(pb + 1);
        }
        if (HASP(3) && IN(pb + 2)) {
            att_combine(F, l);
            REPLOOP(REP_G2)
#pragma unroll 1
            for (int k = 0; k < 3; ++k) { const int u = (F.bid >> 3) + 32 * k; if (u < 96) gla_g2_unit(F, l, 24 * (F.bid & 7) + (u >> 2), u & 3); }
            SEAM(pb + 2);
        }
        if (HASP(4) && IN(pb + 3)) {
            pg8::Gemm g{MIXB, (const bf16*)(wl + W_OUT), M, DMODEL, DMODEL}; pg8::StaticOrder S; S.init(M, DMODEL, F.G, F.bid);
            pg8::EpiResidB E{XB, (float*)(KARG(F)->ws + WS_SSQ + (size_t)(2 * l + 1) * SSQ_STRIDE), nullptr, DMODEL};
            pg8::gemm_phase<pg8::EpiResidB, pg8::StaticOrder, true, true>(F.lds + RING_OFF, g, S, E);
            SEAM(pb + 3);
        }
        if (HASP(5) && IN(pb + 4)) {
            pg8::Gemm g{XB, (const bf16*)(wl + W_1), M, FF, DMODEL}; pg8::StaticOrder S; S.init(M, FF, F.G, F.bid);
            pg8::EpiScaleBf16<1> E{HID, FF, (const float*)(KARG(F)->ws + WS_SSQ + (size_t)(2 * l + 1) * SSQ_STRIDE), 1.0f / DMODEL, EPS};
            REPLOOP(REP_P4) pg8::gemm_phase<pg8::EpiScaleBf16<1>, pg8::StaticOrder, true, true>(F.lds + RING_OFF, g, S, E);
            SEAM(pb + 4);
        }
        if (HASP(6) && IN(pb + 5)) {
            pg8::Gemm g{HID, (const bf16*)(wl + W_2), M, DMODEL, FF}; pg8::StaticOrder S; S.init(M, DMODEL, F.G, F.bid);
            pg8::EpiResidB E{XB, (float*)(KARG(F)->ws + WS_SSQ + (size_t)((2 * l + 2) & 3) * SSQ_STRIDE), (l + 1 < DEPTH) ? nullptr : KARG(F)->out, DMODEL};
            pg8::gemm_phase<pg8::EpiResidB, pg8::StaticOrder, true, true>(F.lds + RING_OFF, g, S, E);
            if (l + 1 < DEPTH) SEAM(pb + 5);
        }
    }
#undef IN
#undef SEAM
}

extern "C" void kernel_launch(void* const* d_in, const int* in_sizes, int n_in, void* d_out, int out_size, void* d_ws, size_t ws_size, hipStream_t stream) {
    static int grid = 0;
    if (grid == 0) {
        if (n_in != 16 || in_sizes[0] != M * DMODEL || out_size != M * DMODEL || ws_size < WS_END2) { fprintf(stderr, "kernel_launch: unexpected shapes (n_in %d, in0 %d, out %d, ws %zu); nothing launched\n", n_in, n_in > 0 ? in_sizes[0] : -1, out_size, ws_size); grid = -1; return; }
        int dev = 0, cus = 0, per_cu = 0;
        if (hipGetDevice(&dev) != hipSuccess || hipDeviceGetAttribute(&cus, hipDeviceAttributeMultiprocessorCount, dev) != hipSuccess) { grid = -1; return; }
        if (hipFuncSetAttribute((const void*)hybrid_fwd, hipFuncAttributeMaxDynamicSharedMemorySize, LDS_BYTES) != hipSuccess) { fprintf(stderr, "kernel_launch: hipFuncSetAttribute failed\n"); grid = -1; return; }
        if (hipOccupancyMaxActiveBlocksPerMultiprocessor(&per_cu, (const void*)hybrid_fwd, NWAVES * 64, LDS_BYTES) != hipSuccess || per_cu < 1)
            fprintf(stderr, "kernel_launch: note: occupancy query reports %d workgroups per CU\n", per_cu);
        (void)hipGetLastError();
        grid = cus;
        if (grid != 256) fprintf(stderr, "kernel_launch: %d CUs (built for 256)\n", grid);
        if (grid > 256) grid = 256;
        grid &= ~7;
    }
    if (grid <= 0) return;
    if (hipMemsetAsync((char*)d_ws + WS_CTL, 0, CTL_ZERO_BYTES, stream) != hipSuccess) { fprintf(stderr, "kernel_launch: memset failed\n"); return; }
    Args a{};
    for (int i = 0; i < 16; ++i) a.in[i] = (const float*)d_in[i];
    a.out = (float*)d_out; a.ws = (unsigned char*)d_ws;
    int lo_ = 0, li = 0;
    for (int p = 0; p < NPHASE; ++p) {
        const int ty = (p == 0) ? 0 : ((p - 1) % 6) + 1;
        const bool cut = (p == NPHASE - 1) || ((CUTMASK >> ty) & 1);
        if (!cut) continue;
        a.li = li; a.ph_lo = lo_; a.ph_hi = p + 1; lo_ = p + 1;
        hipLaunchKernelGGL(hybrid_fwd, dim3(grid), dim3(NWAVES * 64), LDS_BYTES, stream, a);
        const hipError_t le = hipPeekAtLastError();
        if (le != hipSuccess) { fprintf(stderr, "kernel_launch: launch %d failed: %s\n", li, hipGetErrorName(le)); break; }
        ++li;
    }
}
```

```cpp
#include <hip/hip_runtime.h>
#include <cstdio>
#include <cstdint>
namespace pg8 {
#define PG8_LAS __attribute__((address_space(3)))
typedef unsigned short bf16_t;
typedef short bf16x8 __attribute__((ext_vector_type(8)));
typedef float f32x4 __attribute__((ext_vector_type(4)));
typedef unsigned u32x4 __attribute__((ext_vector_type(4)));
constexpr int BM = 256, BK = 64, HALF = 128, HTB = HALF * BK * 2  , STAGE_BYTES = 8 * HTB, NXCD = 8, WGM = 8;

__host__ __device__ __forceinline__ int lds_byte(int r, int c) { const int st = (r >> 4) * 2 + (c >> 5), rr = r & 15, cc = c & 31, ob = rr * 64 + cc * 2; return st * 1024 + (ob ^ (((ob >> 9) & 1) << 5)); }
__host__ __device__ __forceinline__ void stage_rc(int b, int& R, int& C) { const int st = b / 1024, sb = b % 1024, swz = sb ^ (((sb >> 9) & 1) << 5); R = (st >> 1) * 16 + swz / 64; C = (st & 1) * 32 + (swz % 64) / 2; }
__host__ __device__ __forceinline__ int perm32(int rho) { const int n = rho >> 4, i = rho & 15; return 8 * (i >> 2) + 4 * n + (i & 3); }

struct Unit { int pm, pn; };
struct Gemm { const bf16_t* A; const bf16_t* Bt; int M, N, K; };

struct StaticOrder {
    int nM, nN, nwg, G, c;
    __host__ __device__ void init(int M, int N, int G_, int c_) { nM = M / BM; nN = N / BM; nwg = nM * nN; G = G_; c = c_; }
    __host__ __device__ bool next(int i, Unit& u) const {
        const long L = (long)i * G + c; if (L >= nwg) return false;
        int wgid = (int)L; { const int q = nwg / NXCD, r = nwg % NXCD, xcd = wgid % NXCD, off = wgid / NXCD; wgid = (xcd < r ? xcd * (q + 1) : r * (q + 1) + (xcd - r) * q) + off; }
        const int nig = WGM * nN, gid = wgid / nig, fm = gid * WGM, gsz = (nM - fm) < WGM ? (nM - fm) : WGM;
        u.pm = fm + ((wgid % nig) % gsz); u.pn = (wgid % nig) / gsz; return true;
    }
    __device__ __forceinline__ void a_ready(const Unit&) const {}
    __device__ __forceinline__ void done(const Unit&) const {}
};

typedef float f32x2_t __attribute__((ext_vector_type(2))); typedef __bf16 bf16x2_t __attribute__((ext_vector_type(2)));
__device__ __forceinline__ unsigned cvt_pk_bf16(float lo, float hi) { const f32x2_t v = {lo, hi}; return __builtin_bit_cast(unsigned, __builtin_convertvector(v, bf16x2_t)); }
constexpr int SSQ_M = 65536;
__device__ __forceinline__ float row_rstd(const float* ssq, int row, int fq, float inv_n, float eps) {
    const f32x4 p = *(const f32x4*)(ssq + (size_t)row * 16 + 4 * fq);
    float s = (p[0] + p[1]) + (p[2] + p[3]);
    s += __shfl_xor(s, 16); s += __shfl_xor(s, 32);
    return 1.0f / sqrtf(s * inv_n + eps);
}
template <int ACT> struct EpiScaleBf16 {
    static constexpr bool PERM = true, AFTER_DRAIN = false;
    bf16_t* O; int ldc; const float* ssq; float inv_n, eps;
    __device__ __forceinline__ void operator()(const f32x4 (&acc)[2][2][4][2], const Unit& u, int wr, int wc, int fr, int fq) const {
        const int row0 = u.pm * BM + wr * 64 + fr, col0 = u.pn * BM + wc * 32 + 8 * fq;
#pragma unroll
        for (int ai = 0; ai < 2; ++ai)
#pragma unroll
            for (int m = 0; m < 4; ++m) {
                const int row = row0 + ai * HALF + m * 16;
                const float rs = row_rstd(ssq, row, fq, inv_n, eps);
                bf16_t* rowp = O + (size_t)row * ldc + col0;
#pragma unroll
                for (int bj = 0; bj < 2; ++bj) {
                    f32x4 v0 = acc[ai][bj][m][0] * rs, v1 = acc[ai][bj][m][1] * rs;
                    if (ACT == 1) {
#pragma unroll
                        for (int e = 0; e < 4; ++e) { const float a = fmaxf(v0[e], 0.f), b = fmaxf(v1[e], 0.f); v0[e] = a * a; v1[e] = b * b; }
                    }
                    u32x4 w; w.x = cvt_pk_bf16(v0[0], v0[1]); w.y = cvt_pk_bf16(v0[2], v0[3]); w.z = cvt_pk_bf16(v1[0], v1[1]); w.w = cvt_pk_bf16(v1[2], v1[3]);
                    *(u32x4*)(rowp + bj * HALF) = w;
                }
            }
    }
};
struct EpiProj {
    static constexpr bool PERM = true, AFTER_DRAIN = false;
    bf16_t* O; int ldc; const float* ssq; const float* qg; const float* kg; const float* rope; float inv_n, eps;
    __device__ __forceinline__ void operator()(const f32x4 (&acc)[2][2][4][2], const Unit& u, int wr, int wc, int fr, int fq) const {
        const int row0 = u.pm * BM + wr * 64 + fr, colh = u.pn * BM + wc * 64 + 8 * fq;
        const bool qk = u.pn < 3;
        f32x4 g00 = {1.f, 1.f, 1.f, 1.f}, g01 = g00, g10 = g00, g11 = g00; float sc = 1.f;
        if (qk) { const int hg = 4 * u.pn + wc; const float* g = hg < 6 ? qg : kg; sc = hg < 6 ? 0.125f : 1.0f;
            const int d0 = fq < 2 ? 4 * fq : 8 * fq, d1 = fq < 2 ? 4 * fq + 8 : 8 * fq + 4;
            g00 = *(const f32x4*)(g + d0); g01 = *(const f32x4*)(g + d1); g10 = *(const f32x4*)(g + 32 + 8 * fq); g11 = *(const f32x4*)(g + 36 + 8 * fq); }
#pragma unroll
        for (int ai = 0; ai < 2; ++ai)
#pragma unroll
            for (int m = 0; m < 4; ++m) {
                const int row = row0 + ai * HALF + m * 16;
                const float rs = row_rstd(ssq, row, fq, inv_n, eps);
                f32x4 v00 = acc[ai][0][m][0] * rs, v01 = acc[ai][0][m][1] * rs, v10 = acc[ai][1][m][0] * rs, v11 = acc[ai][1][m][1] * rs;
                if (qk) {
                    float ss = 0.f;
#pragma unroll
                    for (int e = 0; e < 4; ++e) ss += (v00[e] * v00[e] + v01[e] * v01[e]) + (v10[e] * v10[e] + v11[e] * v11[e]);
                    ss += __shfl_xor(ss, 16); ss += __shfl_xor(ss, 32);
                    const float r = sc / sqrtf(ss * (1.0f / 64.0f) + eps);
                    v00 = v00 * (g00 * r); v01 = v01 * (g01 * r); v10 = v10 * (g10 * r); v11 = v11 * (g11 * r);
                    const int t = row & 2047;
                    const f32x4 cs = *(const f32x4*)(rope + t * 16 + 4 * (fq & 1)), sn = *(const f32x4*)(rope + t * 16 + 8 + 4 * (fq & 1));
                    const f32x4 ra = v00 * cs - v01 * sn, rb = v01 * cs + v00 * sn;
                    if (fq < 2) { v00 = ra; v01 = rb; }
                }
                bf16_t* rowp = O + (size_t)row * ldc + colh;
                u32x4 w; w.x = cvt_pk_bf16(v00[0], v00[1]); w.y = cvt_pk_bf16(v00[2], v00[3]); w.z = cvt_pk_bf16(v01[0], v01[1]); w.w = cvt_pk_bf16(v01[2], v01[3]);
                *(u32x4*)(rowp) = w;
                w.x = cvt_pk_bf16(v10[0], v10[1]); w.y = cvt_pk_bf16(v10[2], v10[3]); w.z = cvt_pk_bf16(v11[0], v11[1]); w.w = cvt_pk_bf16(v11[2], v11[3]);
                *(u32x4*)(rowp + 32) = w;
            }
    }
};
struct EpiResidDry {
    static constexpr bool PERM = true, AFTER_DRAIN = false;
    const float* base; bf16_t* xb; int ldc;
    __device__ __forceinline__ void operator()(const f32x4 (&acc)[2][2][4][2], const Unit& u, int wr, int wc, int fr, int fq) const {
        const int row0 = u.pm * BM + wr * 64 + fr, col0 = u.pn * BM + wc * 32 + 8 * fq;
#pragma unroll
        for (int ai = 0; ai < 2; ++ai)
#pragma unroll
            for (int m = 0; m < 4; ++m) {
                const int row = row0 + ai * HALF + m * 16;
                const size_t off = (size_t)row * ldc + col0;
#pragma unroll
                for (int bj = 0; bj < 2; ++bj) {
                    const f32x4 b0 = *(const f32x4*)(base + off + bj * HALF), b1 = *(const f32x4*)(base + off + bj * HALF + 4);
                    const f32x4 v0 = acc[ai][bj][m][0] + b0, v1 = acc[ai][bj][m][1] + b1;
                    u32x4 w; w.x = cvt_pk_bf16(v0[0], v0[1]); w.y = cvt_pk_bf16(v0[2], v0[3]); w.z = cvt_pk_bf16(v1[0], v1[1]); w.w = cvt_pk_bf16(v1[2], v1[3]);
                    *(u32x4*)(xb + off + bj * HALF) = w;
                }
                asm volatile("" ::: "memory");
            }
    }
};
struct EpiResidB {
    static constexpr bool PERM = true, AFTER_DRAIN = false;
    bf16_t* xb; float* ssq; float* outf; int ldc;
    __device__ __forceinline__ void operator()(const f32x4 (&acc)[2][2][4][2], const Unit& u, int wr, int wc, int fr, int fq) const {
        const int row0 = u.pm * BM + wr * 64 + fr, col0 = u.pn * BM + wc * 32 + 8 * fq;
#pragma unroll
        for (int ai = 0; ai < 2; ++ai)
#pragma unroll
            for (int m = 0; m < 4; ++m) {
                const int row = row0 + ai * HALF + m * 16;
                const size_t off = (size_t)row * ldc + col0;
                float s = 0.f;
#pragma unroll
                for (int bj = 0; bj < 2; ++bj) {
                    const u32x4 xo = *(const u32x4*)(xb + off + bj * HALF);
                    const f32x4 b0 = {__uint_as_float(xo.x << 16), __uint_as_float(xo.x & 0xffff0000u), __uint_as_float(xo.y << 16), __uint_as_float(xo.y & 0xffff0000u)};
                    const f32x4 b1 = {__uint_as_float(xo.z << 16), __uint_as_float(xo.z & 0xffff0000u), __uint_as_float(xo.w << 16), __uint_as_float(xo.w & 0xffff0000u)};
                    const f32x4 v0 = acc[ai][bj][m][0] + b0, v1 = acc[ai][bj][m][1] + b1;
                    if (outf) { *(f32x4*)(outf + off + bj * HALF) = v0; *(f32x4*)(outf + off + bj * HALF + 4) = v1; }
                    else {
                        u32x4 w; w.x = cvt_pk_bf16(v0[0], v0[1]); w.y = cvt_pk_bf16(v0[2], v0[3]); w.z = cvt_pk_bf16(v1[0], v1[1]); w.w = cvt_pk_bf16(v1[2], v1[3]);
                        *(u32x4*)(xb + off + bj * HALF) = w;
                        s += (v0[0] * v0[0] + v0[1] * v0[1]) + (v0[2] * v0[2] + v0[3] * v0[3]) + (v1[0] * v1[0] + v1[1] * v1[1]) + (v1[2] * v1[2] + v1[3] * v1[3]); }
                }
                if (!outf) { s += __shfl_xor(s, 16); s += __shfl_xor(s, 32);
                    if (fq == 0) ssq[(size_t)row * 16 + 4 * u.pn + wc] = s; }
                asm volatile("" ::: "memory");
            }
    }
};
struct EpiResid {
    static constexpr bool PERM = true, AFTER_DRAIN = false;
    const float* base; float* out; bf16_t* xb; float* ssq; int ldc;
    __device__ __forceinline__ void operator()(const f32x4 (&acc)[2][2][4][2], const Unit& u, int wr, int wc, int fr, int fq) const {
        const int row0 = u.pm * BM + wr * 64 + fr, col0 = u.pn * BM + wc * 32 + 8 * fq;
#pragma unroll
        for (int ai = 0; ai < 2; ++ai)
#pragma unroll
            for (int m = 0; m < 4; ++m) {
                const int row = row0 + ai * HALF + m * 16;
                const size_t off = (size_t)row * ldc + col0;
                float s = 0.f;
#pragma unroll
                for (int bj = 0; bj < 2; ++bj) {
                    const f32x4 b0 = *(const f32x4*)(base + off + bj * HALF), b1 = *(const f32x4*)(base + off + bj * HALF + 4);
                    const f32x4 v0 = acc[ai][bj][m][0] + b0, v1 = acc[ai][bj][m][1] + b1;
                    *(f32x4*)(out + off + bj * HALF) = v0; *(f32x4*)(out + off + bj * HALF + 4) = v1;
                    u32x4 w; w.x = cvt_pk_bf16(v0[0], v0[1]); w.y = cvt_pk_bf16(v0[2], v0[3]); w.z = cvt_pk_bf16(v1[0], v1[1]); w.w = cvt_pk_bf16(v1[2], v1[3]);
                    *(u32x4*)(xb + off + bj * HALF) = w;
                    s += (v0[0] * v0[0] + v0[1] * v0[1]) + (v0[2] * v0[2] + v0[3] * v0[3]) + (v1[0] * v1[0] + v1[1] * v1[1]) + (v1[2] * v1[2] + v1[3] * v1[3]);
                }
                s += __shfl_xor(s, 16); s += __shfl_xor(s, 32);
                if (fq == 0) ssq[((size_t)u.pn * SSQ_M + row) * 4 + wc] = s;
                asm volatile("" ::: "memory");
            }
    }
};
template <class Epi, class Sched, bool ALIGN_EPI = false, bool SP2 = false>
__device__ __forceinline__ void gemm_phase(PG8_LAS unsigned char* lds, const Gemm g, const Sched& S, const Epi& E) {
    int tid = threadIdx.x; asm volatile("" : "+v"(tid));
    const int wid = __builtin_amdgcn_readfirstlane(tid >> 6), lane = tid & 63, wr = wid >> 2, wc = wid & 3, fr = lane & 15, fq = lane >> 4;
    const int K = g.K, nt = K / BK;
    unsigned voffA[2], voffB[2];
#pragma unroll
    for (int i = 0; i < 2; ++i) { int R, C; stage_rc(tid * 16 + i * 8192, R, C); const int Rb = Epi::PERM ? ((R & ~31) + perm32(R & 31)) : R;
        voffA[i] = (unsigned)(R * K + C) * 2u; voffB[i] = (unsigned)(Rb * K + C) * 2u; }
    const size_t kstep = (size_t)(BK * 2);
    const size_t hstep = (size_t)HALF * K * 2;
    const size_t tstep = 2 * hstep;
    const unsigned ldsw = (unsigned)wid * 1024u;
    const int aoff = lds_byte(wr * 64 + fr, fq * 8), boff = lds_byte(wc * 32 + fr, fq * 8);
#define PG8_SA(b, h) (((b) * 2 + (h)) * HTB)
#define PG8_SB(b, h) ((4 + (b) * 2 + (h)) * HTB)
#define PG8_STAGE(bufoff, gbase, voff) do { _Pragma("unroll") for (int _i = 0; _i < 2; ++_i) \
        __builtin_amdgcn_global_load_lds((const unsigned*)((const char*)(gbase) + (voff)[_i]), (PG8_LAS unsigned*)(lds + (bufoff) + ldsw + _i * 8192), 16, 0, 0); } while (0)
#define PG8_LDA(dst, b, h) do { _Pragma("unroll") for (int m = 0; m < 4; ++m) _Pragma("unroll") for (int k = 0; k < 2; ++k) dst[m][k] = *(const PG8_LAS bf16x8*)(lds + PG8_SA(b, h) + aoff + m * 2048 + k * 1024); } while (0)
#define PG8_LDB(dst, b, h) do { _Pragma("unroll") for (int n = 0; n < 2; ++n) _Pragma("unroll") for (int k = 0; k < 2; ++k) dst[n][k] = *(const PG8_LAS bf16x8*)(lds + PG8_SB(b, h) + boff + n * 2048 + k * 1024); } while (0)
#define PG8_MMA(ai, bj, At, Bt) do { __builtin_amdgcn_s_setprio(1); _Pragma("unroll") for (int m = 0; m < 4; ++m) _Pragma("unroll") for (int n = 0; n < 2; ++n) _Pragma("unroll") for (int k = 0; k < 2; ++k) \
        acc[ai][bj][m][n] = __builtin_amdgcn_mfma_f32_16x16x32_bf16(Bt[n][k], At[m][k], acc[ai][bj][m][n], 0, 0, 0); __builtin_amdgcn_s_setprio(0); } while (0)
#define PG8_WAIT_V(n) asm volatile("s_waitcnt vmcnt(" #n ")" ::: "memory")
#define PG8_WAIT_L(n) asm volatile("s_waitcnt lgkmcnt(" #n ")" ::: "memory")
#define PG8_BAR __builtin_amdgcn_s_barrier()
#define PG8_SCHED __builtin_amdgcn_sched_barrier(0)
    Unit cur, nxt; int ui = 0;
    if (!S.next(0, cur)) return;
    f32x4 acc[2][2][4][2];
#pragma unroll
    for (int a = 0; a < 2; ++a)
#pragma unroll
        for (int b = 0; b < 2; ++b)
#pragma unroll
            for (int m = 0; m < 4; ++m)
#pragma unroll
                for (int n = 0; n < 2; ++n) acc[a][b][m][n] = (f32x4){0.f, 0.f, 0.f, 0.f};
    bf16x8 At[4][2], B0[2][2], B1[2][2];
    const char* cA = (const char*)g.A + (size_t)cur.pm * tstep; const char* cB = (const char*)g.Bt + (size_t)cur.pn * tstep;
    S.a_ready(cur);
    if constexpr (SP2) {
        PG8_STAGE(PG8_SB(0, 0), cB, voffB); PG8_STAGE(PG8_SB(0, 1), cB + hstep, voffB); PG8_STAGE(PG8_SA(0, 0), cA, voffA); PG8_STAGE(PG8_SA(0, 1), cA + hstep, voffA);
        if (wr == 1) PG8_BAR;
        PG8_WAIT_V(2); PG8_BAR;
        PG8_STAGE(PG8_SB(1, 0), cB + kstep, voffB); PG8_STAGE(PG8_SA(1, 0), cA + kstep, voffA); PG8_STAGE(PG8_SB(1, 1), cB + hstep + kstep, voffB);
        PG8_WAIT_V(6); PG8_BAR;
    } else {
        PG8_STAGE(PG8_SB(0, 0), cB, voffB); PG8_STAGE(PG8_SA(0, 0), cA, voffA); PG8_STAGE(PG8_SB(0, 1), cB + hstep, voffB); PG8_STAGE(PG8_SA(0, 1), cA + hstep, voffA);
        if (wr == 1) PG8_BAR;
        PG8_WAIT_V(4); PG8_BAR;
        PG8_STAGE(PG8_SB(1, 0), cB + kstep, voffB); PG8_STAGE(PG8_SA(1, 0), cA + kstep, voffA); PG8_STAGE(PG8_SB(1, 1), cB + hstep + kstep, voffB);
        PG8_WAIT_V(6); PG8_BAR;
    }
    for (;;) {
        const bool has_next = S.next(ui + 1, nxt);
        const char* nA = has_next ? (const char*)g.A + (size_t)nxt.pm * tstep : cA; const char* nB = has_next ? (const char*)g.Bt + (size_t)nxt.pn * tstep : cB;
        for (int t = 0; t < nt; t += 2) {
            const bool last = (t == nt - 2);
            const char* a1 = cA + (size_t)(t + 1) * kstep;
            const char* a2 = last ? nA : cA + (size_t)(t + 2) * kstep; const char* b2 = last ? nB : cB + (size_t)(t + 2) * kstep;
            const char* a3 = a2 + kstep; const char* b3 = b2 + kstep;
            if (last && has_next) S.a_ready(nxt);
            if constexpr (SP2) {
            PG8_LDB(B0, 0, 0); PG8_LDB(B1, 0, 1); PG8_SCHED; PG8_LDA(At, 0, 0); PG8_STAGE(PG8_SA(1, 1), a1 + hstep, voffA);
            PG8_WAIT_V(8); PG8_WAIT_L(0); PG8_BAR; PG8_MMA(0, 0, At, B0); PG8_MMA(0, 1, At, B1); PG8_BAR; PG8_SCHED;
            PG8_LDA(At, 0, 1); PG8_STAGE(PG8_SB(0, 0), b2, voffB); PG8_STAGE(PG8_SB(0, 1), b2 + hstep, voffB); PG8_STAGE(PG8_SA(0, 0), a2, voffA);
            PG8_WAIT_V(8); PG8_WAIT_L(0); PG8_BAR; PG8_MMA(1, 0, At, B0); PG8_MMA(1, 1, At, B1); PG8_BAR; PG8_SCHED;
            PG8_LDB(B0, 1, 0); PG8_LDB(B1, 1, 1); PG8_SCHED; PG8_LDA(At, 1, 0); PG8_STAGE(PG8_SA(0, 1), a2 + hstep, voffA);
            PG8_WAIT_V(8); PG8_WAIT_L(0); PG8_BAR; PG8_MMA(0, 0, At, B0); PG8_MMA(0, 1, At, B1); PG8_BAR; PG8_SCHED;
            PG8_LDA(At, 1, 1); PG8_STAGE(PG8_SB(1, 0), b3, voffB); PG8_STAGE(PG8_SB(1, 1), b3 + hstep, voffB); PG8_STAGE(PG8_SA(1, 0), a3, voffA);
            PG8_WAIT_V(8); PG8_WAIT_L(0); PG8_BAR; PG8_MMA(1, 0, At, B0); PG8_MMA(1, 1, At, B1); PG8_BAR; PG8_SCHED;
            } else {
            PG8_LDB(B0, 0, 0); PG8_SCHED; PG8_LDA(At, 0, 0); PG8_STAGE(PG8_SA(1, 1), a1 + hstep, voffA);
            PG8_WAIT_L(8); PG8_BAR; PG8_WAIT_L(0); PG8_MMA(0, 0, At, B0); PG8_BAR; PG8_SCHED;
            PG8_LDB(B1, 0, 1); PG8_STAGE(PG8_SB(0, 0), b2, voffB);
            PG8_BAR; PG8_WAIT_L(0); PG8_MMA(0, 1, At, B1); PG8_BAR;
            PG8_LDA(At, 0, 1); PG8_STAGE(PG8_SA(0, 0), a2, voffA);
            PG8_BAR; PG8_WAIT_L(0); PG8_MMA(1, 0, At, B0); PG8_BAR; PG8_SCHED;
            PG8_STAGE(PG8_SB(0, 1), b2 + hstep, voffB);
            PG8_WAIT_V(6); PG8_BAR; PG8_MMA(1, 1, At, B1); PG8_BAR;
            PG8_LDB(B0, 1, 0); PG8_SCHED; PG8_LDA(At, 1, 0); PG8_STAGE(PG8_SA(0, 1), a2 + hstep, voffA);
            PG8_WAIT_L(8); PG8_BAR; PG8_WAIT_L(0); PG8_MMA(0, 0, At, B0); PG8_BAR; PG8_SCHED;
            PG8_LDB(B1, 1, 1); PG8_STAGE(PG8_SB(1, 0), b3, voffB);
            PG8_BAR; PG8_WAIT_L(0); PG8_MMA(0, 1, At, B1); PG8_BAR;
            PG8_LDA(At, 1, 1); PG8_STAGE(PG8_SA(1, 0), a3, voffA);
            PG8_BAR; PG8_WAIT_L(0); PG8_MMA(1, 0, At, B0); PG8_BAR; PG8_SCHED;
            PG8_STAGE(PG8_SB(1, 1), b3 + hstep, voffB);
            PG8_WAIT_V(6); PG8_BAR; PG8_MMA(1, 1, At, B1); PG8_BAR;
            }
        }
        if constexpr (ALIGN_EPI) { if (wr == 0) PG8_BAR; }
        if constexpr (!Epi::AFTER_DRAIN) { E(acc, cur, wr, wc, fr, fq); S.done(cur); }
        if (!has_next) break;
#pragma unroll
        for (int a = 0; a < 2; ++a)
#pragma unroll
            for (int b = 0; b < 2; ++b)
#pragma unroll
                for (int m = 0; m < 4; ++m)
#pragma unroll
                    for (int n = 0; n < 2; ++n) acc[a][b][m][n] = (f32x4){0.f, 0.f, 0.f, 0.f};
        cur = nxt; cA = nA; cB = nB; ++ui;
        if constexpr (ALIGN_EPI) { if (wr == 1) PG8_BAR; }
    }
    PG8_WAIT_V(0);
    if constexpr (!ALIGN_EPI) { if (wr == 0) PG8_BAR; }
    PG8_BAR;
    if constexpr (Epi::AFTER_DRAIN) { E.fused(acc, cur, wr, wc, fr, fq, lds, wid, lane); S.done(cur); }
#undef PG8_SA
#undef PG8_SB
#undef PG8_STAGE
#undef PG8_LDA
#undef PG8_LDB
#undef PG8_MMA
#undef PG8_WAIT_V
#undef PG8_WAIT_L
#undef PG8_BAR
#undef PG8_SCHED
}
}
constexpr int NWAVES = 8;
constexpr int BATCH = 32, SEQ = 2048, DMODEL = 1024, DEPTH = 2, FF = 4096;
constexpr int M = BATCH * SEQ;
constexpr int NPROJ = 3072, IN_DIM = 2832;
constexpr int QA = 0, KA = 384, VA = 768, QG = 1152, KG = 1344, VG = 1536, RG = 1920, ZS = 2304, AG = 2816;
constexpr float EPS = 1e-6f;
constexpr int NPHASE = 1 + 6 * DEPTH;
#ifndef MK_N_LAUNCHES
#define MK_N_LAUNCHES 1
#endif
#ifndef CUTMASK
#define CUTMASK 0
#endif
constexpr int N_LAUNCHES = MK_N_LAUNCHES;

constexpr size_t MiB = 1u << 20;
constexpr size_t WS_CTL = 0, CTL_ZERO_BYTES = 1 * MiB;
constexpr size_t WS_ROPE = 1 * MiB;
constexpr size_t WS_WSG = 1 * MiB + 256 * 1024;
constexpr size_t WS_W = 2 * MiB, W_LAYER = 24 * MiB;
constexpr size_t W_IN = 0, W_OUT = 6 * MiB, W_1 = 8 * MiB, W_2 = 16 * MiB;
constexpr size_t WS_SSQ = 50 * MiB, SSQ_STRIDE = 4 * MiB;
constexpr size_t WS_XB = 66 * MiB;
constexpr size_t WS_BC = 194 * MiB, WS_KVS = 242 * MiB;
constexpr size_t WS_DEC = 290 * MiB, DEC_STRIDE = 1 * MiB;
constexpr size_t WS_AGS = 292 * MiB, AGS_STRIDE = 6 * MiB, WS_AGD = 304 * MiB, AGD_STRIDE = 512 * 1024;
constexpr size_t WS_LSE = 305 * MiB, LSE_STRIDE = 5 * MiB;
constexpr size_t WS_PROJ = 320 * MiB, WS_MIX = 704 * MiB, WS_HID = 320 * MiB, WS_END = 832 * MiB;
constexpr size_t WS_OR = 832 * MiB, WS_END2 = WS_OR + (size_t)3 * 65536 * 384 * 2;
static_assert(WS_W + DEPTH * W_LAYER <= WS_SSQ && WS_SSQ + 4 * SSQ_STRIDE <= WS_XB && WS_XB + (size_t)M * DMODEL * 2 <= WS_BC && WS_BC + (size_t)6144 * 2048 * 4 <= WS_KVS && WS_KVS + (size_t)6144 * 2048 * 4 <= WS_DEC, "ws map");
static_assert(WS_DEC + DEPTH * DEC_STRIDE <= WS_AGS && WS_AGS + DEPTH * AGS_STRIDE <= WS_AGD && WS_AGD + DEPTH * AGD_STRIDE <= WS_LSE && WS_LSE + DEPTH * LSE_STRIDE <= WS_PROJ && (size_t)3 * 192 * 2048 * 4 <= LSE_STRIDE, "ws map");
static_assert(WS_PROJ + (size_t)M * NPROJ * 2 <= WS_MIX && WS_MIX + (size_t)M * DMODEL * 2 <= WS_END && WS_HID + (size_t)M * FF * 2 <= WS_END && WS_END2 <= 1024 * MiB, "ws map");
constexpr int CW_BAR = 4096;

constexpr int RING_OFF = 0, RING_BYTES = 131072;
constexpr int LDSCTL_OFF = RING_BYTES, MISC_OFF = LDSCTL_OFF + 320;
constexpr int LDS_BYTES = 147456;

#define GAS __attribute__((address_space(1)))
#define LAS __attribute__((address_space(3)))
typedef unsigned short bf16;
typedef unsigned v4u __attribute__((ext_vector_type(4)));
typedef unsigned v2u __attribute__((ext_vector_type(2)));
typedef float f32x4 __attribute__((ext_vector_type(4)));
typedef float f32x16 __attribute__((ext_vector_type(16)));
typedef short bf16x8 __attribute__((ext_vector_type(8)));
typedef short s16x4 __attribute__((ext_vector_type(4)));
typedef GAS unsigned gu32;
#define LDS_WAIT() asm volatile("s_waitcnt lgkmcnt(0)" ::: "memory")
#define VM_WAIT() asm volatile("s_waitcnt vmcnt(0)" ::: "memory")
__device__ __forceinline__ unsigned pk2(float lo, float hi) { return pg8::cvt_pk_bf16(lo, hi); }
__device__ __forceinline__ float bflo(unsigned w) { return __uint_as_float(w << 16); }
__device__ __forceinline__ float bfhi(unsigned w) { return __uint_as_float(w & 0xffff0000u); }
__device__ __forceinline__ float bf1(unsigned short h) { return __uint_as_float((unsigned)h << 16); }
__device__ __forceinline__ void unpack8(const v4u w, float* f) { f[0] = bflo(w.x); f[1] = bfhi(w.x); f[2] = bflo(w.y); f[3] = bfhi(w.y); f[4] = bflo(w.z); f[5] = bfhi(w.z); f[6] = bflo(w.w); f[7] = bfhi(w.w); }
__device__ __forceinline__ bf16x8 as_frag(const v4u w) { return __builtin_bit_cast(bf16x8, w); }
__device__ __forceinline__ bf16x8 tr_frag(const LAS unsigned char* p_lo, const LAS unsigned char* p_hi) {
    const s16x4 lo = __builtin_amdgcn_ds_read_tr16_b64_v4i16((LAS s16x4*)p_lo), hi = __builtin_amdgcn_ds_read_tr16_b64_v4i16((LAS s16x4*)p_hi);
    return (bf16x8){lo[0], lo[1], lo[2], lo[3], hi[0], hi[1], hi[2], hi[3]};
}
__device__ __forceinline__ int tr_lane_off(int lane) { return ((lane >> 4) & 1) * 32 + (lane & 3) * 8 + ((lane & 15) >> 2) * 64; }
#define MFMA32(a, b, c) __builtin_amdgcn_mfma_f32_32x32x16_bf16((a), (b), (c), 0, 0, 0)
__device__ __forceinline__ int crow(int r, int hi) { return (r & 3) + 8 * (r >> 2) + 4 * hi; }
__device__ __forceinline__ float wave_sum(float v) {
#pragma unroll
    for (int o = 1; o < 64; o <<= 1) v += __shfl_xor(v, o);
    return v;
}
#define XB_TMO      128
#define XB_XCNT(j)  (256  + 64 * (j))
#define XB_XSUB(j)  (1280 + 64 * (j))
#define XB_XGEN(j)  (2304 + 64 * (j))
#define XB_TOP      3328
#define XB_TOPGEN   3392
#define XCD_BAR_WORDS 3456
#define XB_SPIN_CAP (1u << 18)

__device__ __forceinline__ unsigned xb_ld(unsigned* p)              { return __hip_atomic_load(p, __ATOMIC_RELAXED, __HIP_MEMORY_SCOPE_AGENT); }
__device__ __forceinline__ unsigned xb_add(unsigned* p, unsigned v) { return __hip_atomic_fetch_add(p, v, __ATOMIC_RELAXED, __HIP_MEMORY_SCOPE_AGENT); }
__device__ __forceinline__ unsigned xb_xcc_id() { return (unsigned)__builtin_amdgcn_s_getreg((3 << 11) | 20) & 0xFu; }
#define XB_SPIN(cond, bar) do { unsigned _sp = 0; while (cond) { __builtin_amdgcn_s_sleep(1); \
    if ((++_sp & 255u) == 0u) { if (xb_ld(&(bar)[XB_TMO])) break; if (_sp > XB_SPIN_CAP) { atomicAdd(&(bar)[XB_TMO], 1u); break; } } } } while (0)

struct XcdBarrier {
    unsigned* bar; unsigned x;
    volatile LAS unsigned* st;
};

__device__ __forceinline__ XcdBarrier xcd_barrier_post(unsigned* bar, volatile LAS unsigned* st) {
    XcdBarrier b; b.bar = bar; b.x = xb_xcc_id(); b.st = st;
    if (threadIdx.x == 0) (void)xb_add(&bar[XB_XCNT(b.x)], 1u);
    return b;
}
__device__ __forceinline__ void xcd_barrier_complete(unsigned* bar, unsigned x, unsigned& nloc, unsigned& nx) {
    const unsigned G = gridDim.x * gridDim.y * gridDim.z;
    unsigned sum, cnt, mine, sp = 0u;
    for (;;) {
        sum = 0u; cnt = 0u; mine = 0u;
#pragma unroll
        for (unsigned j = 0; j < 16; ++j) { const unsigned c = xb_ld(&bar[XB_XCNT(j)]); sum += c; cnt += (c > 0u) ? 1u : 0u; mine = (j == x) ? c : mine; }
        if (sum == G) break;
        __builtin_amdgcn_s_sleep(1);
        if ((++sp & 255u) == 0u) { if (xb_ld(&bar[XB_TMO])) break; if (sp > XB_SPIN_CAP) { atomicAdd(&bar[XB_TMO], 1u); break; } }
    }
    nloc = mine > 0u ? mine : 1u; nx = cnt > 0u ? cnt : 1u;
}

__device__ __forceinline__ void xcd_barrier(const XcdBarrier& b) {
    asm volatile("s_waitcnt vmcnt(0)" ::: "memory");
    __syncthreads();
    if (threadIdx.x == 0) {
        unsigned* bar = b.bar;
        __builtin_amdgcn_s_waitcnt(0);
        unsigned nloc = b.st[0], nx = b.st[1];
        if (nloc == 0u) { xcd_barrier_complete(bar, b.x, nloc, nx); b.st[0] = nloc; b.st[1] = nx; }
        const unsigned old = xb_add(&bar[XB_XSUB(b.x)], 1u);
        const unsigned gen = old / nloc;
        if (old + 1u == (gen + 1u) * nloc) {
            __builtin_amdgcn_fence(__ATOMIC_RELEASE, "agent");
            asm volatile("s_waitcnt vmcnt(0)" ::: "memory");
            const unsigned og = xb_add(&bar[XB_TOP], 1u);
            const unsigned tg = og / nx;
            if (og + 1u == (tg + 1u) * nx) xb_add(&bar[XB_TOPGEN], 1u);
            else XB_SPIN(xb_ld(&bar[XB_TOPGEN]) == tg, bar);
            __builtin_amdgcn_fence(__ATOMIC_ACQUIRE, "agent");
            xb_add(&bar[XB_XGEN(b.x)], 1u);
            asm volatile("s_waitcnt vmcnt(0)" ::: "memory");
        } else {
            XB_SPIN(xb_ld(&bar[XB_XGEN(b.x)]) == gen, bar);
            __builtin_amdgcn_fence(__ATOMIC_ACQUIRE, "agent");
            asm volatile("s_waitcnt vmcnt(0)" ::: "memory");
        }
    }
    __syncthreads();
}
struct Args { const float* in[16]; float* out; unsigned char* ws; int ph_lo, ph_hi, li, pad; };
#define CAS __attribute__((address_space(4)))
struct Frame {
    const CAS Args* K;
    LAS unsigned char* lds;
    volatile LAS unsigned* MISC;
    gu32* ctl;
    int tid, lane, wave, G, bid;
};
__device__ __forceinline__ const CAS Args* KARG(const Frame& F) { const CAS Args* a = F.K; asm volatile("" : "+s"(a)); return a; }
enum { I_X = 0, I_N1G, I_WIN, I_QNG, I_KNG, I_WA2, I_BA, I_GNG, I_LNG, I_LNB, I_SGW, I_SGB, I_WOUT, I_N2G, I_W1, I_W2 };

__device__ __forceinline__ float gelu_tanh(float x) {
    const float u = 0.7978845608028654f * (x + 0.044715f * x * x * x);
    return x / (1.0f + __expf(-2.0f * u));
}
__device__ __forceinline__ float log_sigmoid(float x) { return fminf(x, 0.f) - log1pf(__expf(-fabsf(x))); }

template <int MODE>
__device__ __forceinline__ void p0_transpose_item(const float* W, int K, int Nsrc, int Ndst, const float* g, bf16* WT, LAS float* scr, int item, int lane) {
    const int nblk = Ndst / 32, kb = item / nblk, nb = item % nblk, k0 = 64 * kb, n0 = 32 * nb;
    const int nn = n0 + (lane & 31);
    int src = nn;
    if (MODE == 1) {
        const int pn = nn >> 8, ct = nn & 255, wcq = (ct >> 5) & 3, sg = 32 * (ct >> 7) + (ct & 31);
        const int dm = (pn < 3 && sg < 16) ? (4 * (sg >> 3) + (sg & 3) + 8 * ((sg >> 2) & 1)) : sg;
        const int nat = 256 * pn + 64 * wcq + dm;
        src = nat < 2304 ? nat : (nat < 2816 ? nat + 16 : (nat < 2832 ? nat - 512 : -1)); }
#pragma unroll 8
    for (int i = 0; i < 32; ++i) { const int kk = 2 * i + (lane >> 5);
        float v = 0.f; if (src >= 0) { v = W[(size_t)(k0 + kk) * Nsrc + src]; if (g) v *= g[k0 + kk]; }
        scr[kk * 33 + (lane & 31)] = v; }
    LDS_WAIT(); asm volatile("" ::: "memory");
    const int c = lane & 7;
#pragma unroll
    for (int j = 0; j < 4; ++j) { const int n = (lane >> 3) + 8 * j; const LAS float* s = scr + (8 * c) * 33 + n;
        v4u o; o.x = pk2(s[0 * 33], s[1 * 33]); o.y = pk2(s[2 * 33], s[3 * 33]); o.z = pk2(s[4 * 33], s[5 * 33]); o.w = pk2(s[6 * 33], s[7 * 33]);
        *(GAS v4u*)(WT + (size_t)(n0 + n) * K + k0 + 8 * c) = o; }
    LDS_WAIT(); asm volatile("s_waitcnt vmcnt(0)" ::: "memory");
}
__device__ __forceinline__ void p0_prologue(Frame& F) {
    LAS float* scr = (LAS float*)(F.lds + RING_OFF + F.wave * 16384);
    const int gw = F.bid * NWAVES + F.wave, NGW = F.G * NWAVES;
    constexpr int I_IN = 16 * 96, I_OUT = 16 * 32, I_1 = 16 * 128, I_2 = 64 * 32, I_L = I_IN + I_OUT + I_1 + I_2;
    for (int it = gw; it < DEPTH * I_L; it += NGW) {
        const int l = it / I_L; int r = it % I_L;
        unsigned char* wl = KARG(F)->ws + WS_W + (size_t)l * W_LAYER;
        if (r < I_IN) { p0_transpose_item<1>(KARG(F)->in[I_WIN] + (size_t)l * DMODEL * IN_DIM, DMODEL, IN_DIM, NPROJ, KARG(F)->in[I_N1G] + l * DMODEL, (bf16*)(wl + W_IN), scr, r, F.lane); continue; } r -= I_IN;
        if (r < I_OUT) { p0_transpose_item<0>(KARG(F)->in[I_WOUT] + (size_t)l * DMODEL * DMODEL, DMODEL, DMODEL, DMODEL, nullptr, (bf16*)(wl + W_OUT), scr, r, F.lane); continue; } r -= I_OUT;
        if (r < I_1) { p0_transpose_item<0>(KARG(F)->in[I_W1] + (size_t)l * DMODEL * FF, DMODEL, FF, FF, KARG(F)->in[I_N2G] + l * DMODEL, (bf16*)(wl + W_1), scr, r, F.lane); continue; } r -= I_1;
        p0_transpose_item<0>(KARG(F)->in[I_W2] + (size_t)l * FF * DMODEL, FF, DMODEL, DMODEL, nullptr, (bf16*)(wl + W_2), scr, r, F.lane);
    }
    {
        bf16* XB = (bf16*)(KARG(F)->ws + WS_XB); float* SSQ = (float*)(KARG(F)->ws + WS_SSQ);
        for (int ml = (F.bid >> 3) * NWAVES + F.wave; ml < 8192; ml += 32 * NWAVES) { const int m = (F.bid & 7) * 8192 + ml;
            const GAS f32x4* xr = (const GAS f32x4*)(KARG(F)->in[I_X] + (size_t)m * DMODEL) + F.lane;
            f32x4 v[4]; float s = 0.f;
#pragma unroll
            for (int j = 0; j < 4; ++j) { v[j] = xr[64 * j]; s += (v[j].x * v[j].x + v[j].y * v[j].y) + (v[j].z * v[j].z + v[j].w * v[j].w); }
            s = wave_sum(s);
            GAS v2u* o8 = (GAS v2u*)(XB + (size_t)m * DMODEL) + F.lane;
#pragma unroll
            for (int j = 0; j < 4; ++j) { v2u w; w.x = pk2(v[j].x, v[j].y); w.y = pk2(v[j].z, v[j].w); o8[64 * j] = w; }
            if (F.lane < 16) SSQ[(size_t)m * 16 + F.lane] = (F.lane == 0) ? s : 0.f;
            asm volatile("s_waitcnt vmcnt(0)" ::: "memory");
        }
    }
    const int gt = F.bid * (NWAVES * 64) + F.tid, NT = F.G * NWAVES * 64;
    {
        float* ROPE = (float*)(KARG(F)->ws + WS_ROPE);
        for (int idx = gt; idx < SEQ * 8; idx += NT) { const int t = idx >> 3, i = idx & 7;
            const float inv = powf(500000.0f, -(float)i * 0.125f); const float ang = (float)t * inv;
            float sn, cs; sincosf(ang, &sn, &cs); ROPE[t * 16 + i] = cs; ROPE[t * 16 + 8 + i] = sn; }
    }
    {
        bf16* WSG = (bf16*)(KARG(F)->ws + WS_WSG); const float* sw = KARG(F)->in[I_SGW];
        for (int idx = gt; idx < DEPTH * 4 * 128 * 128 / 2; idx += NT) { const int e = 2 * idx, t = (e >> 7) & 127, s = e & 127;
            const float a = (s <= t) ? sw[e] : 0.f, b = (s + 1 <= t) ? sw[e + 1] : 0.f; ((GAS unsigned*)WSG)[idx] = pk2(a, b); }
    }
}

__device__ __forceinline__ void qknorm_all(Frame& F, int l) {
    bf16* P = (bf16*)(KARG(F)->ws + WS_PROJ); const float* ROPE = (const float*)(KARG(F)->ws + WS_ROPE);
    const int gt = F.bid * (NWAVES * 64) + F.tid, NT = F.G * NWAVES * 64;
    for (int p = gt; p < M * 12; p += NT) {
        const int row = p / 12, slot = p - row * 12;
        bf16* ptr = P + (size_t)row * NPROJ + slot * 64;
        const float* g = (slot < 6 ? KARG(F)->in[I_QNG] : KARG(F)->in[I_KNG]) + l * 64;
        float x[64]; float ss = 0.f;
#pragma unroll
        for (int c = 0; c < 8; ++c) { const v4u w = *(const GAS v4u*)(ptr + 8 * c); unpack8(w, x + 8 * c); }
#pragma unroll
        for (int d = 0; d < 64; ++d) ss += x[d] * x[d];
        const float r = 1.0f / sqrtf(ss * (1.0f / 64.0f) + EPS);
#pragma unroll
        for (int c = 0; c < 16; ++c) { const f32x4 gv = *(const f32x4*)(g + 4 * c); x[4 * c] *= r * gv[0]; x[4 * c + 1] *= r * gv[1]; x[4 * c + 2] *= r * gv[2]; x[4 * c + 3] *= r * gv[3]; }
        const int t = row & (SEQ - 1);
        const f32x4 c0 = *(const f32x4*)(ROPE + t * 16), c1 = *(const f32x4*)(ROPE + t * 16 + 4), s0 = *(const f32x4*)(ROPE + t * 16 + 8), s1 = *(const f32x4*)(ROPE + t * 16 + 12);
#pragma unroll
        for (int i = 0; i < 8; ++i) { const float cs = i < 4 ? c0[i & 3] : c1[i & 3], sn = i < 4 ? s0[i & 3] : s1[i & 3]; const float a = x[i], b = x[i + 8]; x[i] = a * cs - b * sn; x[i + 8] = b * cs + a * sn; }
        const float sc = slot < 6 ? 0.125f : 1.0f;
#pragma unroll
        for (int c = 0; c < 8; ++c) { v4u w; w.x = pk2(x[8 * c] * sc, x[8 * c + 1] * sc); w.y = pk2(x[8 * c + 2] * sc, x[8 * c + 3] * sc); w.z = pk2(x[8 * c + 4] * sc, x[8 * c + 5] * sc); w.w = pk2(x[8 * c + 6] * sc, x[8 * c + 7] * sc);
            *(GAS v4u*)(ptr + 8 * c) = w; }
    }
}
__device__ __forceinline__ void stage_v64(const bf16* src, LAS unsigned char* vl, int lane) {
#pragma unroll
    for (int c = 0; c < 8; ++c) { const int idx = 64 * c + lane, db = idx >> 8, row = (idx >> 2) & 63, c4 = idx & 3;
        const v4u w = *(const GAS v4u*)(src + (size_t)row * NPROJ + db * 32 + c4 * 8); *(LAS v4u*)(vl + idx * 16) = w; }
}
__device__ __forceinline__ void gla_g1_unit(Frame& F, int l, int bh, int grp) {
    int tid = F.tid; asm volatile("" : "+v"(tid));
    const int lane = tid & 63, wave = F.wave, i = lane & 31, hh = lane >> 5;
    const int b = bh / 6, h = bh - b * 6, n = grp * 8 + wave;
    const bf16* P = (const bf16*)(KARG(F)->ws + WS_PROJ) + ((size_t)b * SEQ + n * 64) * NPROJ;
    LAS unsigned char* wl = F.lds + RING_OFF + wave * 16384;
    LAS unsigned char* vl = wl; LAS unsigned char* kl = wl + 8192;
    stage_v64(P + VG + h * 64, vl, lane);
#pragma unroll
    for (int c = 0; c < 4; ++c) { const int idx = 64 * c + lane, row = idx >> 2, c4 = idx & 3;
        const v4u w = *(const GAS v4u*)(P + (size_t)row * NPROJ + KG + h * 32 + c4 * 8); *(LAS v4u*)(kl + idx * 16) = w; }
    bf16x8 wfrag;
    { const float* wa2 = KARG(F)->in[I_WA2] + (size_t)l * 16 * 192 + (8 * hh) * 192 + h * 32 + i;
      v4u w; w.x = pk2(wa2[0], wa2[192]); w.y = pk2(wa2[2 * 192], wa2[3 * 192]); w.z = pk2(wa2[4 * 192], wa2[5 * 192]); w.w = pk2(wa2[6 * 192], wa2[7 * 192]); wfrag = as_frag(w); }
    const float bias = KARG(F)->in[I_BA][l * 192 + h * 32 + i];
    float bc[2][16]; float carry = 0.f;
#pragma unroll
    for (int T = 0; T < 2; ++T) {
        const bf16x8 afrag = as_frag(*(const GAS v4u*)(P + (size_t)(32 * T + i) * NPROJ + AG + 8 * hh));
        f32x16 D = {}; D = MFMA32(afrag, wfrag, D);
        float tb[4];
#pragma unroll
        for (int q = 0; q < 4; ++q) { float run = 0.f;
#pragma unroll
            for (int e = 0; e < 4; ++e) { const float x = D[4 * q + e] + bias; run += (fminf(x, 0.f) - __logf(1.0f + __expf(-fabsf(x)))) * (1.0f / 16.0f); bc[T][4 * q + e] = run; }
            tb[q] = run; }
        float off = carry;
#pragma unroll
        for (int q = 0; q < 4; ++q) { const float ob = __shfl_xor(tb[q], 32); const float o = off + (hh ? ob : 0.f);
#pragma unroll
            for (int e = 0; e < 4; ++e) bc[T][4 * q + e] += o;
            off += tb[q] + ob; }
        carry = off;
    }
    const float blast = carry;
    const size_t cidx = (size_t)bh * 32 + n;
    { float* BC = (float*)(KARG(F)->ws + WS_BC) + cidx * 2048;
#pragma unroll
      for (int T = 0; T < 2; ++T)
#pragma unroll
        for (int r = 0; r < 16; ++r) BC[(32 * T + crow(r, hh)) * 32 + i] = bc[T][r]; asm volatile("s_waitcnt vmcnt(0)" ::: "memory"); }
    f32x16 kv0 = {}, kv1 = {};
    const int tro = tr_lane_off(lane);
    bf16x8 af[4], vfr[4][2];
#pragma unroll
    for (int s = 0; s < 4; ++s) { const int T = s >> 1, rb = 8 * (s & 1); float ke[8];
#pragma unroll
        for (int e = 0; e < 8; ++e) { const int t = 32 * T + crow(rb + e, hh); ke[e] = bf1(*(const LAS unsigned short*)(kl + t * 64 + i * 2)) * __expf(blast - bc[T][rb + e]); }
        v4u w; w.x = pk2(ke[0], ke[1]); w.y = pk2(ke[2], ke[3]); w.z = pk2(ke[4], ke[5]); w.w = pk2(ke[6], ke[7]);
        af[s] = as_frag(w); const int t0 = 32 * T + 16 * (s & 1) + 4 * hh;
        vfr[s][0] = tr_frag(vl + t0 * 64 + tro, vl + (t0 + 8) * 64 + tro);
        vfr[s][1] = tr_frag(vl + 4096 + t0 * 64 + tro, vl + 4096 + (t0 + 8) * 64 + tro); }
#pragma unroll
    for (int s = 0; s < 4; ++s) { kv0 = MFMA32(af[s], vfr[s][0], kv0); kv1 = MFMA32(af[s], vfr[s][1], kv1); }
    { LAS float* kvl = (LAS float*)vl;
#pragma unroll
      for (int r = 0; r < 16; ++r) { kvl[crow(r, hh) * 64 + i] = kv0[r]; kvl[crow(r, hh) * 64 + 32 + i] = kv1[r]; }
      if (hh == 0) ((LAS float*)kl)[i] = __expf(blast); }
    __syncthreads();
    {
        const int e0 = tid * 4, si = e0 >> 6;
        float* KV = (float*)(KARG(F)->ws + WS_KVS) + ((size_t)bh * 32 + grp * 8) * 2048 + e0;
        f32x4 agg = {0.f, 0.f, 0.f, 0.f}; float dprod = 1.f;
#pragma unroll
        for (int k = 0; k < 8; ++k) { const LAS unsigned char* wk = F.lds + RING_OFF + k * 16384;
            const f32x4 kvk = *(const LAS f32x4*)(wk + e0 * 4); const float dk = *(const LAS float*)(wk + 8192 + si * 4);
            *(GAS f32x4*)(KV + (size_t)k * 2048) = kvk; agg = agg * dk + kvk; dprod *= dk;
            if ((tid & 15) == 0) ((float*)(KARG(F)->ws + WS_DEC + l * DEC_STRIDE))[((size_t)bh * 32 + grp * 8 + k) * 32 + si] = dk; }
        *(GAS f32x4*)((float*)(KARG(F)->ws + WS_AGS + l * AGS_STRIDE) + ((size_t)bh * 4 + grp) * 2048 + e0) = agg;
        if ((tid & 15) == 0) ((float*)(KARG(F)->ws + WS_AGD + l * AGD_STRIDE))[((size_t)bh * 4 + grp) * 32 + si] = dprod;
        asm volatile("s_waitcnt vmcnt(0)" ::: "memory");
    }
    __syncthreads();
}
__device__ __forceinline__ void sg_unit(Frame& F, int l, int b, int n) {
    int lane = F.lane; asm volatile("" : "+v"(lane));
    const int wave = F.wave, c31 = lane & 31, hh = lane >> 5, g = wave >> 1, par = wave & 1;
    const bf16* P = (const bf16*)(KARG(F)->ws + WS_PROJ) + ((size_t)b * SEQ + n * 128) * NPROJ;
    bf16* MIX = (bf16*)(KARG(F)->ws + WS_MIX) + ((size_t)b * SEQ + n * 128) * DMODEL;
    LAS unsigned char* VV = F.lds + RING_OFF;
    const bf16* WSG = (const bf16*)(KARG(F)->ws + WS_WSG) + (size_t)(l * 4 + g) * 128 * 128;
    v4u zv[8], wfr[5][2]; v2u uw[2][8]; float bias[2];
#pragma unroll
    for (int it = 0; it < 8; ++it) zv[it] = *(const GAS v4u*)(P + (size_t)(16 * wave + 2 * it + hh) * NPROJ + ZS + 256 + 8 * c31);
#pragma unroll
    for (int p = 0; p < 5; ++p) { const int tb = par ? (p < 2 ? 1 : 2) : (p == 0 ? 0 : 3), sb = par ? (p < 2 ? p : p - 2) : (p == 0 ? 0 : p - 1);
#pragma unroll
        for (int ks = 0; ks < 2; ++ks) wfr[p][ks] = *(const GAS v4u*)(WSG + (size_t)(32 * tb + c31) * 128 + 32 * sb + 16 * ks + 8 * hh); }
#pragma unroll
    for (int q = 0; q < 2; ++q) { const int t = 32 * (par ? (1 + q) : (3 * q)) + c31;
        bias[q] = KARG(F)->in[I_SGB][(l * 4 + g) * 128 + t];
#pragma unroll
        for (int cg = 0; cg < 8; ++cg) uw[q][cg] = *(const GAS v2u*)(P + (size_t)t * NPROJ + ZS + 64 * g + 32 * (cg >> 2) + 8 * (cg & 3) + 4 * hh); }
    float g8[8], b8[8];
    { const float* lg = KARG(F)->in[I_LNG] + l * 256 + 8 * c31; const float* lb = KARG(F)->in[I_LNB] + l * 256 + 8 * c31;
#pragma unroll
      for (int e = 0; e < 8; ++e) { g8[e] = lg[e]; b8[e] = lb[e]; } }
    asm volatile("s_waitcnt vmcnt(0)" : "+v"(zv[0]), "+v"(zv[1]), "+v"(zv[2]), "+v"(zv[3]), "+v"(zv[4]), "+v"(zv[5]), "+v"(zv[6]), "+v"(zv[7]),
                 "+v"(wfr[0][0]), "+v"(wfr[0][1]), "+v"(wfr[1][0]), "+v"(wfr[1][1]), "+v"(wfr[2][0]), "+v"(wfr[2][1]), "+v"(wfr[3][0]), "+v"(wfr[3][1]), "+v"(wfr[4][0]), "+v"(wfr[4][1]),
                 "+v"(bias[0]), "+v"(bias[1]) :: "memory");
    asm volatile("" : "+v"(uw[0][0]), "+v"(uw[0][1]), "+v"(uw[0][2]), "+v"(uw[0][3]), "+v"(uw[0][4]), "+v"(uw[0][5]), "+v"(uw[0][6]), "+v"(uw[0][7]),
                 "+v"(uw[1][0]), "+v"(uw[1][1]), "+v"(uw[1][2]), "+v"(uw[1][3]), "+v"(uw[1][4]), "+v"(uw[1][5]), "+v"(uw[1][6]), "+v"(uw[1][7]));
    asm volatile("" : "+v"(g8[0]), "+v"(g8[1]), "+v"(g8[2]), "+v"(g8[3]), "+v"(g8[4]), "+v"(g8[5]), "+v"(g8[6]), "+v"(g8[7]), "+v"(b8[0]), "+v"(b8[1]), "+v"(b8[2]), "+v"(b8[3]), "+v"(b8[4]), "+v"(b8[5]), "+v"(b8[6]), "+v"(b8[7]));
#pragma unroll
    for (int it = 0; it < 8; ++it) { const int s = 16 * wave + 2 * it + hh;
        float x[8]; unpack8(zv[it], x); float sum = 0.f;
#pragma unroll
        for (int e = 0; e < 8; ++e) { x[e] = gelu_tanh(x[e]); sum += x[e]; }
#pragma unroll
        for (int o = 1; o < 32; o <<= 1) sum += __shfl_xor(sum, o);
        const float mean = sum * (1.0f / 256.0f); float sq = 0.f;
#pragma unroll
        for (int e = 0; e < 8; ++e) { x[e] -= mean; sq += x[e] * x[e]; }
#pragma unroll
        for (int o = 1; o < 32; o <<= 1) sq += __shfl_xor(sq, o);
        const float rstd = 1.0f / sqrtf(sq * (1.0f / 256.0f) + EPS);
#pragma unroll
        for (int e = 0; e < 8; ++e) x[e] = x[e] * rstd * g8[e] + b8[e];
        v4u o; o.x = pk2(x[0], x[1]); o.y = pk2(x[2], x[3]); o.z = pk2(x[4], x[5]); o.w = pk2(x[6], x[7]);
        *(LAS v4u*)(VV + (c31 >> 3) * 16384 + ((c31 >> 2) & 1) * 8192 + s * 64 + (c31 & 3) * 16) = o; }
    __syncthreads();
    {
        const int tro = tr_lane_off(lane);
        const LAS unsigned char* vg = VV + g * 16384;
        f32x16 Dq[2][2] = {};
        bf16x8 vcur[2][2], vnxt[2][2];
#pragma unroll
        for (int ks = 0; ks < 2; ++ks) { const int s0 = 16 * ks + 8 * hh;
            vcur[ks][0] = tr_frag(vg + s0 * 64 + tro, vg + (s0 + 4) * 64 + tro); vcur[ks][1] = tr_frag(vg + 8192 + s0 * 64 + tro, vg + 8192 + (s0 + 4) * 64 + tro); }
#pragma unroll
        for (int p = 0; p < 5; ++p) {
            if (p < 4) { const int sbn = par ? (p + 1 < 2 ? p + 1 : p - 1) : p;
#pragma unroll
                for (int ks = 0; ks < 2; ++ks) { const int s0 = 32 * sbn + 16 * ks + 8 * hh;
                    vnxt[ks][0] = tr_frag(vg + s0 * 64 + tro, vg + (s0 + 4) * 64 + tro); vnxt[ks][1] = tr_frag(vg + 8192 + s0 * 64 + tro, vg + 8192 + (s0 + 4) * 64 + tro); } }
#pragma unroll
            for (int ks = 0; ks < 2; ++ks) { const bf16x8 wf = as_frag(wfr[p][ks]);
                if (p == 0 || (p == 1 && par)) { Dq[0][0] = MFMA32(vcur[ks][0], wf, Dq[0][0]); Dq[0][1] = MFMA32(vcur[ks][1], wf, Dq[0][1]); }
                else { Dq[1][0] = MFMA32(vcur[ks][0], wf, Dq[1][0]); Dq[1][1] = MFMA32(vcur[ks][1], wf, Dq[1][1]); } }
#pragma unroll
            for (int ks = 0; ks < 2; ++ks) { vcur[ks][0] = vnxt[ks][0]; vcur[ks][1] = vnxt[ks][1]; } }
#pragma unroll
        for (int q = 0; q < 2; ++q) { const int t = 32 * (par ? (1 + q) : (3 * q)) + c31;
#pragma unroll
            for (int cg = 0; cg < 8; ++cg) { const int cb = cg >> 2, g4 = cg & 3, c0 = 32 * cb + 8 * g4 + 4 * hh;
                const float u0 = gelu_tanh(bflo(uw[q][cg].x)), u1 = gelu_tanh(bfhi(uw[q][cg].x)), u2 = gelu_tanh(bflo(uw[q][cg].y)), u3 = gelu_tanh(bfhi(uw[q][cg].y));
                v2u o; o.x = pk2(u0 * (Dq[q][cb][4 * g4] + bias[q]), u1 * (Dq[q][cb][4 * g4 + 1] + bias[q])); o.y = pk2(u2 * (Dq[q][cb][4 * g4 + 2] + bias[q]), u3 * (Dq[q][cb][4 * g4 + 3] + bias[q]));
                *(GAS v2u*)(MIX + (size_t)t * DMODEL + 768 + 64 * g + c0) = o; } }
        asm volatile("s_waitcnt vmcnt(0)" ::: "memory");
    }
    __syncthreads();
}
__device__ __forceinline__ void gla_g2_unit(Frame& F, int l, int bh, int grp) {
    int tid = F.tid; asm volatile("" : "+v"(tid));
    const int lane = tid & 63, wave = F.wave, c31 = lane & 31, hh = lane >> 5;
    const int b = bh / 6, h = bh - b * 6;
    LAS unsigned char* ST = F.lds + RING_OFF;
    LAS unsigned char* vl = F.lds + RING_OFF + 32768 + wave * 8192;
    const int n0 = grp * 8;
    {
        const int e0 = tid * 4, si = e0 >> 6, sj = e0 & 63;
        const float* KV = (const float*)(KARG(F)->ws + WS_KVS) + (size_t)bh * 32 * 2048 + e0;
        const float* DEC = (const float*)(KARG(F)->ws + WS_DEC + l * DEC_STRIDE) + (size_t)bh * 32 * 32 + si;
        const float* AGS = (const float*)(KARG(F)->ws + WS_AGS + l * AGS_STRIDE) + (size_t)bh * 4 * 2048 + e0;
        const float* AGD = (const float*)(KARG(F)->ws + WS_AGD + l * AGD_STRIDE) + (size_t)bh * 4 * 32 + si;
        f32x4 ag[3]; float ad[3]; f32x4 kvm[7]; float dm[7];
#pragma unroll
        for (int g = 0; g < 3; ++g) { const int gg = g < grp ? g : 0; ag[g] = *(const GAS f32x4*)(AGS + (size_t)gg * 2048); ad[g] = AGD[gg * 32]; }
#pragma unroll
        for (int k = 0; k < 7; ++k) { kvm[k] = *(const GAS f32x4*)(KV + (size_t)(n0 + k) * 2048); dm[k] = DEC[(n0 + k) * 32]; }
        f32x4 st = {0.f, 0.f, 0.f, 0.f};
#pragma unroll
        for (int g = 0; g < 3; ++g) if (g < grp) st = st * ad[g] + ag[g];
        LAS unsigned char* sp = ST + (sj >> 5) * 2048 + si * 64 + (sj & 31) * 2;
#pragma unroll
        for (int k = 0; k < 8; ++k) {
            v2u w; w.x = pk2(st[0], st[1]); w.y = pk2(st[2], st[3]); *(LAS v2u*)(sp + k * 4096) = w;
            if (k < 7) st = st * dm[k] + kvm[k];
        }
    }
    __syncthreads();
    {
        const int n = n0 + wave;
        const size_t tok0 = (size_t)b * SEQ + n * 64;
        const bf16* P = (const bf16*)(KARG(F)->ws + WS_PROJ) + tok0 * NPROJ;
        bf16* MIX = (bf16*)(KARG(F)->ws + WS_MIX) + tok0 * DMODEL;
        const float* BC = (const float*)(KARG(F)->ws + WS_BC) + ((size_t)bh * 32 + n) * 2048;
        stage_v64(P + VG + h * 64, vl, lane);
        bf16x8 qf[2][2], kf[2][2];
#pragma unroll
        for (int tb = 0; tb < 2; ++tb)
#pragma unroll
            for (int s = 0; s < 2; ++s) { const int t = 32 * tb + c31, i0 = 16 * s + 8 * hh;
                const v4u qw = *(const GAS v4u*)(P + (size_t)t * NPROJ + QG + h * 32 + i0), kw = *(const GAS v4u*)(P + (size_t)t * NPROJ + KG + h * 32 + i0);
                const f32x4 b0 = *(const GAS f32x4*)(BC + t * 32 + i0), b1 = *(const GAS f32x4*)(BC + t * 32 + i0 + 4);
                float q[8], k[8]; unpack8(qw, q); unpack8(kw, k);
#pragma unroll
                for (int e = 0; e < 8; ++e) { const float bb = e < 4 ? b0[e & 3] : b1[e & 3]; q[e] *= 0.17677669529663687f * __expf(bb); k[e] *= __expf(-bb); }
                v4u w; w.x = pk2(q[0], q[1]); w.y = pk2(q[2], q[3]); w.z = pk2(q[4], q[5]); w.w = pk2(q[6], q[7]); qf[tb][s] = as_frag(w);
                w.x = pk2(k[0], k[1]); w.y = pk2(k[2], k[3]); w.z = pk2(k[4], k[5]); w.w = pk2(k[6], k[7]); kf[tb][s] = as_frag(w); }
        const int tro = tr_lane_off(lane);
        f32x16 OT[2][2];
#pragma unroll
        for (int jb = 0; jb < 2; ++jb)
#pragma unroll
            for (int tb = 0; tb < 2; ++tb) OT[jb][tb] = (f32x16){};
        const LAS unsigned char* stw = ST + wave * 4096;
        { bf16x8 sfr[2][2];
#pragma unroll
          for (int jb = 0; jb < 2; ++jb)
#pragma unroll
            for (int s = 0; s < 2; ++s) { const int r0 = 16 * s + 8 * hh; sfr[jb][s] = tr_frag(stw + jb * 2048 + r0 * 64 + tro, stw + jb * 2048 + (r0 + 4) * 64 + tro); }
#pragma unroll
          for (int jb = 0; jb < 2; ++jb)
#pragma unroll
            for (int s = 0; s < 2; ++s)
#pragma unroll
                for (int tb = 0; tb < 2; ++tb) OT[jb][tb] = MFMA32(sfr[jb][s], qf[tb][s], OT[jb][tb]); }
#pragma unroll
        for (int xt = 0; xt < 3; ++xt) { const int sb = xt >> 1, tb = (xt + 1) >> 1;
            f32x16 X = {};
#pragma unroll
            for (int s = 0; s < 2; ++s) X = MFMA32(kf[sb][s], qf[tb][s], X);
            if (sb == tb) {
#pragma unroll
                for (int r = 0; r < 16; ++r) if (crow(r, hh) > c31) X[r] = 0.f; }
            bf16x8 xfr[2], vfx[2][2];
#pragma unroll
            for (int s2 = 0; s2 < 2; ++s2) {
                v4u w; w.x = pk2(X[8 * s2], X[8 * s2 + 1]); w.y = pk2(X[8 * s2 + 2], X[8 * s2 + 3]); w.z = pk2(X[8 * s2 + 4], X[8 * s2 + 5]); w.w = pk2(X[8 * s2 + 6], X[8 * s2 + 7]);
                xfr[s2] = as_frag(w); const int r0 = 32 * sb + 16 * s2 + 4 * hh;
#pragma unroll
                for (int jb = 0; jb < 2; ++jb) vfx[s2][jb] = tr_frag(vl + jb * 4096 + r0 * 64 + tro, vl + jb * 4096 + (r0 + 8) * 64 + tro); }
#pragma unroll
            for (int s2 = 0; s2 < 2; ++s2)
#pragma unroll
                for (int jb = 0; jb < 2; ++jb) OT[jb][tb] = MFMA32(vfx[s2][jb], xfr[s2], OT[jb][tb]); }
        const float* gn = KARG(F)->in[I_GNG] + l * 64;
#pragma unroll
        for (int tb = 0; tb < 2; ++tb) { const int t = 32 * tb + c31; float ss = 0.f;
#pragma unroll
            for (int jb = 0; jb < 2; ++jb)
#pragma unroll
                for (int r = 0; r < 16; ++r) ss += OT[jb][tb][r] * OT[jb][tb][r];
            ss += __shfl_xor(ss, 32);
            const float rstd = 1.0f / sqrtf(ss * (1.0f / 64.0f) + EPS);
#pragma unroll
            for (int jb = 0; jb < 2; ++jb)
#pragma unroll
                for (int g4 = 0; g4 < 4; ++g4) { const int j0 = 32 * jb + 8 * g4 + 4 * hh;
                    const v2u rw = *(const GAS v2u*)(P + (size_t)t * NPROJ + RG + h * 64 + j0); const f32x4 gv = *(const f32x4*)(gn + j0);
                    float rr[4] = {bflo(rw.x), bfhi(rw.x), bflo(rw.y), bfhi(rw.y)}; float y[4];
#pragma unroll
                    for (int e = 0; e < 4; ++e) { const float sl = rr[e] / (1.0f + __expf(-rr[e])); y[e] = OT[jb][tb][4 * g4 + e] * rstd * gv[e] * sl; }
                    v2u o; o.x = pk2(y[0], y[1]); o.y = pk2(y[2], y[3]);
                    *(GAS v2u*)(MIX + (size_t)t * DMODEL + 384 + h * 64 + j0) = o; } asm volatile("s_waitcnt vmcnt(0)" ::: "memory"); }
    }
    __syncthreads();
}
constexpr int ATT_KPITCH = 144, ATT_NKEYS = 384, ATT_VOFF = ATT_NKEYS * ATT_KPITCH  , ATT_VDB = ATT_NKEYS * 64  ;
constexpr int ATT_UNITS = 3 * 1536, ATT_PER_WG = ATT_UNITS / 256;
struct AttUnit { int r, bh, d, rho, I0, sub; };
__device__ __forceinline__ AttUnit att_decode(int bid, int k) {
    const int xl = bid & 7, rk = bid >> 3; AttUnit a; a.r = k / 6; const int v = rk + 32 * (k - 6 * a.r);
    a.bh = 24 * xl + (v >> 3); a.sub = ((v & 7) + k) & 7;
    if (a.r == 0) { a.d = 1; a.rho = 0; a.I0 = 256 * a.sub; } else if (a.r == 1) { a.d = 4; a.rho = a.sub >> 1; a.I0 = 256 * (a.sub & 1); } else { a.d = 16; a.rho = 2 * a.sub; a.I0 = 0; }
    return a;
}
#define ATT_STAGE_LOAD(U, ST) do { const int b_ = (U).bh / 6, h_ = (U).bh - b_ * 6; \
    const bf16* src_ = Pall + (size_t)b_ * SEQ * NPROJ + (skv ? VA : KA) + h_ * 64 + sc8 * 8; \
    _Pragma("unroll") for (int s_ = 0; s_ < 12; ++s_) { \
        int rho_ = (U).rho, ikb_ = (U).I0 - 128 + 32 * s_; if ((U).r == 2) { rho_ += (s_ >> 2) & 1; ikb_ = 32 * (s_ & 3); } \
        ikb_ = ikb_ < 0 ? 0 : ikb_;     \
        ST[s_] = *(const GAS v4u*)(src_ + (size_t)(rho_ + (U).d * (ikb_ + skk)) * NPROJ); } } while (0)
#define ATT_STAGE_WRITE(U, ST) do { \
    _Pragma("unroll") for (int s_ = 0; s_ < 12; ++s_) *(LAS v4u*)(sdst + s_ * (skv ? 32 * 64 : 32 * ATT_KPITCH)) = ST[s_]; } while (0)
#define ATT_Q_LOAD(U, QF) do { const int b_ = (U).bh / 6, h_ = (U).bh - b_ * 6; \
    const int rho_ = (U).rho + ((U).r == 2 ? (wave >> 2) : 0), i0_ = (U).I0 + 32 * ((U).r == 2 ? (wave & 3) : wave); \
    const bf16* qp_ = Pall + ((size_t)b_ * SEQ + rho_ + (U).d * (i0_ + j)) * NPROJ + QA + h_ * 64 + 8 * hh; \
    _Pragma("unroll") for (int s_ = 0; s_ < 4; ++s_) QF[s_] = *(const GAS v4u*)(qp_ + 16 * s_); } while (0)
__device__ __forceinline__ void att_phase(Frame& F, int l) {
    int tid = F.tid; asm volatile("" : "+v"(tid));
    const int lane = tid & 63, wave = F.wave, j = lane & 31, hh = lane >> 5;
    const bf16* Pall = (const bf16*)(KARG(F)->ws + WS_PROJ);
    bf16* OR = l == 0 ? (bf16*)(KARG(F)->ws + WS_OR) : (bf16*)KARG(F)->out; float* LSE = (float*)(KARG(F)->ws + WS_LSE + l * LSE_STRIDE);
    LAS unsigned char* Kimg = F.lds + RING_OFF; LAS unsigned char* Vimg = F.lds + RING_OFF + ATT_VOFF;
    const int skv = tid >> 8, skk = (tid & 255) >> 3, sc8 = tid & 7;
    LAS unsigned char* sdst = skv ? (Vimg + (sc8 >> 2) * ATT_VDB + skk * 64 + (sc8 & 3) * 16) : (Kimg + skk * ATT_KPITCH + sc8 * 16);
    const int tro = tr_lane_off(lane);
    v4u st[12], qn[4];
    int bidq = F.bid; asm volatile("" : "+s"(bidq));
    AttUnit cur = att_decode(bidq, 0);
    ATT_STAGE_LOAD(cur, st); ATT_Q_LOAD(cur, qn);
#pragma unroll 1
    for (int k = 0; k < ATT_PER_WG; ++k) {
        asm volatile("s_waitcnt vmcnt(0)" : "+v"(st[0]), "+v"(st[1]), "+v"(st[2]), "+v"(st[3]), "+v"(st[4]), "+v"(st[5]), "+v"(st[6]), "+v"(st[7]), "+v"(st[8]), "+v"(st[9]), "+v"(st[10]), "+v"(st[11]),
                     "+v"(qn[0]), "+v"(qn[1]), "+v"(qn[2]), "+v"(qn[3]) :: "memory");
        ATT_STAGE_WRITE(cur, st);
        bf16x8 qf[4];
#pragma unroll
        for (int s = 0; s < 4; ++s) qf[s] = as_frag(qn[s]);
        const AttUnit nxt = att_decode(bidq, (k + 1 < ATT_PER_WG) ? k + 1 : k);
        if (k + 1 < ATT_PER_WG) { ATT_STAGE_LOAD(nxt, st); ATT_Q_LOAD(nxt, qn); }
        __syncthreads();
        {
            const int b = cur.bh / 6, h = cur.bh - b * 6;
            const int wq = (cur.r == 2) ? (wave & 3) : wave;
            const int i0 = cur.I0 + 32 * wq, rho = cur.rho + ((cur.r == 2) ? (wave >> 2) : 0);
            const int slot0 = (cur.r == 2) ? ((wave >> 2) * 4 + wq - 4) : wq;
            int kt = (i0 >= 128) ? 0 : ((128 - i0) >> 5);
            f32x16 O0 = {}, O1 = {}; float m = -1e30f, lsum = 0.f;
#pragma unroll 1
            for (; kt < 5; ++kt) {
                bf16x8 kf[4];
                { const LAS unsigned char* kp = Kimg + ((slot0 + kt) * 32 + j) * ATT_KPITCH + hh * 16;
#pragma unroll
                  for (int s = 0; s < 4; ++s) kf[s] = *(const LAS bf16x8*)(kp + 32 * s); }
                f32x16 S = {};
#pragma unroll
                for (int s = 0; s < 4; ++s) S = MFMA32(kf[s], qf[s], S);
                if (kt == 0) {
#pragma unroll
                    for (int r = 0; r < 16; ++r) if (crow(r, hh) < j) S[r] = -1e30f; }
                if (kt == 4) {
#pragma unroll
                    for (int r = 0; r < 16; ++r) if (crow(r, hh) > j) S[r] = -1e30f; }
                float mt = S[0];
#pragma unroll
                for (int r = 1; r < 16; ++r) mt = fmaxf(mt, S[r]);
                mt = fmaxf(mt, __shfl_xor(mt, 32));
                const float mn = fmaxf(m, mt), alpha = __expf(m - mn); m = mn;
                float ps = 0.f;
#pragma unroll
                for (int r = 0; r < 16; ++r) { S[r] = __expf(S[r] - mn); ps += S[r]; }
                lsum = lsum * alpha + ps;
#pragma unroll
                for (int r = 0; r < 16; ++r) { O0[r] *= alpha; O1[r] *= alpha; }
                const LAS unsigned char* vb = Vimg + (slot0 + kt) * 32 * 64 + tro;
                bf16x8 vf[2][2], pf[2];
#pragma unroll
                for (int s2 = 0; s2 < 2; ++s2) { const int r0 = 16 * s2 + 4 * hh;
                    v4u w; w.x = pk2(S[8 * s2], S[8 * s2 + 1]); w.y = pk2(S[8 * s2 + 2], S[8 * s2 + 3]); w.z = pk2(S[8 * s2 + 4], S[8 * s2 + 5]); w.w = pk2(S[8 * s2 + 6], S[8 * s2 + 7]);
                    pf[s2] = as_frag(w);
                    vf[s2][0] = tr_frag(vb + r0 * 64, vb + (r0 + 8) * 64);
                    vf[s2][1] = tr_frag(vb + ATT_VDB + r0 * 64, vb + ATT_VDB + (r0 + 8) * 64); }
#pragma unroll
                for (int s2 = 0; s2 < 2; ++s2) { O0 = MFMA32(vf[s2][0], pf[s2], O0); O1 = MFMA32(vf[s2][1], pf[s2], O1); }
            }
            const float ltot = lsum + __shfl_xor(lsum, 32), inv = 1.0f / ltot, lse = m + __logf(ltot);
            const size_t tok = (size_t)cur.r * M + (size_t)b * SEQ + rho + cur.d * (i0 + j);
            bf16* rp = OR + tok * 384 + h * 64;
#pragma unroll
            for (int g4 = 0; g4 < 4; ++g4) { const int d0 = 8 * g4 + 4 * hh;
                v2u w; w.x = pk2(O0[4 * g4] * inv, O0[4 * g4 + 1] * inv); w.y = pk2(O0[4 * g4 + 2] * inv, O0[4 * g4 + 3] * inv); *(GAS v2u*)(rp + d0) = w;
                w.x = pk2(O1[4 * g4] * inv, O1[4 * g4 + 1] * inv); w.y = pk2(O1[4 * g4 + 2] * inv, O1[4 * g4 + 3] * inv); *(GAS v2u*)(rp + 32 + d0) = w; }
            if (hh == 0) LSE[((size_t)cur.r * 192 + cur.bh) * 2048 + rho * (2048 / cur.d) + i0 + j] = lse;
        }
        __syncthreads();
        cur = nxt;
    }
}
#undef ATT_STAGE_LOAD
#undef ATT_STAGE_WRITE
#undef ATT_Q_LOAD
__device__ __forceinline__ void att_combine(Frame& F, int l) {
    const bf16* OR = l == 0 ? (const bf16*)(KARG(F)->ws + WS_OR) : (const bf16*)KARG(F)->out; const float* LSE = (const float*)(KARG(F)->ws + WS_LSE + l * LSE_STRIDE);
    bf16* MIX = (bf16*)(KARG(F)->ws + WS_MIX);
    int tq = F.tid; asm volatile("" : "+v"(tq));
    const int gt = (F.bid >> 3) * (NWAVES * 64) + tq, tokx = (F.bid & 7) * 8192;
    constexpr int NT = 32 * NWAVES * 64;
#pragma unroll 1
    for (int ib = 0; ib < 6; ++ib) {
        v4u va[4], vb[4], vc[4]; float l0[4], l1[4], l2[4];
#pragma unroll
        for (int u = 0; u < 4; ++u) { const int g = gt + (4 * ib + u) * NT, tl = g / 48, pc = g - tl * 48, hd = pc >> 3, tok = tokx + tl;
            const int bq_ = tok >> 11, p_ = tok & 2047; const size_t lb = (size_t)(bq_ * 6 + hd) * 2048;
            l0[u] = LSE[lb + p_]; l1[u] = LSE[(size_t)192 * 2048 + lb + (p_ & 3) * 512 + (p_ >> 2)]; l2[u] = LSE[(size_t)384 * 2048 + lb + (p_ & 15) * 128 + (p_ >> 4)];
            va[u] = *(const GAS v4u*)(OR + (size_t)tok * 384 + pc * 8); vb[u] = *(const GAS v4u*)(OR + ((size_t)M + tok) * 384 + pc * 8); vc[u] = *(const GAS v4u*)(OR + ((size_t)2 * M + tok) * 384 + pc * 8); }
        asm volatile("s_waitcnt vmcnt(0)" : "+v"(va[0]), "+v"(va[1]), "+v"(va[2]), "+v"(va[3]), "+v"(vb[0]), "+v"(vb[1]), "+v"(vb[2]), "+v"(vb[3]), "+v"(vc[0]), "+v"(vc[1]), "+v"(vc[2]), "+v"(vc[3]),
                     "+v"(l0[0]), "+v"(l0[1]), "+v"(l0[2]), "+v"(l0[3]), "+v"(l1[0]), "+v"(l1[1]), "+v"(l1[2]), "+v"(l1[3]), "+v"(l2[0]), "+v"(l2[1]), "+v"(l2[2]), "+v"(l2[3]) :: "memory");
#pragma unroll
        for (int u = 0; u < 4; ++u) { const int g = gt + (4 * ib + u) * NT, tl = g / 48, pc = g - tl * 48, tok = tokx + tl;
            const float mx = fmaxf(l0[u], fmaxf(l1[u], l2[u])); float w0 = __expf(l0[u] - mx), w1 = __expf(l1[u] - mx), w2 = __expf(l2[u] - mx);
            const float wi = 1.0f / (w0 + w1 + w2); w0 *= wi; w1 *= wi; w2 *= wi;
            float fa[8], fb[8], fc[8]; unpack8(va[u], fa); unpack8(vb[u], fb); unpack8(vc[u], fc);
            float o[8];
#pragma unroll
            for (int e = 0; e < 8; ++e) o[e] = w0 * fa[e] + w1 * fb[e] + w2 * fc[e];
            v4u w; w.x = pk2(o[0], o[1]); w.y = pk2(o[2], o[3]); w.z = pk2(o[4], o[5]); w.w = pk2(o[6], o[7]);
            *(GAS v4u*)(MIX + (size_t)tok * DMODEL + pc * 8) = w; }
        asm volatile("s_waitcnt vmcnt(0)" ::: "memory");
    }
}
__global__ void __launch_bounds__(NWAVES * 64, 2) hybrid_fwd(const Args args) {
    extern __shared__ __attribute__((aligned(16))) unsigned char lds[];
    Frame F;
    F.lds = (LAS unsigned char*)lds;
    F.MISC = (volatile LAS unsigned*)(F.lds + MISC_OFF);
    F.tid = threadIdx.x; F.lane = F.tid & 63; F.wave = __builtin_amdgcn_readfirstlane(F.tid >> 6);
    F.G = gridDim.x; F.bid = blockIdx.x;
    F.K = (const CAS Args*)__builtin_amdgcn_kernarg_segment_ptr(); F.ctl = (gu32*)(args.ws + WS_CTL);
    for (int u = F.tid; u < LDS_BYTES / 4; u += NWAVES * 64) ((LAS unsigned*)(F.lds))[u] = 0u;
    __syncthreads();
    XcdBarrier bar; bar.bar = (unsigned*)(F.ctl + CW_BAR) + args.li * XCD_BAR_WORDS; bar.x = 0; bar.st = nullptr;
    if (true) bar = xcd_barrier_post((unsigned*)(F.ctl + CW_BAR) + args.li * XCD_BAR_WORDS, F.MISC + 8);
    const int lo = args.ph_lo, hi = args.ph_hi;
#ifndef REP_P0
#define REP_P0 1
#endif
#ifndef DRY35
#define DRY35 0
#endif
#ifndef REP_P1
#define REP_P1 1
#endif
#ifndef REP_P4
#define REP_P4 1
#endif
#ifndef REP_ATT
#define REP_ATT 1
#endif
#ifndef REP_G2
#define REP_G2 1
#endif
#ifndef REP_G1
#define REP_G1 1
#endif
#ifndef REP_SG
#define REP_SG 1
#endif
#define REPLOOP(N) _Pragma("unroll 1") for (int rep_ = 0, reps_ = __builtin_amdgcn_readfirstlane(N); rep_ < reps_; ++rep_)
#ifndef PH_MASK
#define PH_MASK 127
#endif
#define HASP(j) (((PH_MASK) >> (j)) & 1)
#define IN(k) (lo <= (k) && (k) < hi)
#define SEAM(k) do { if (IN(k) && IN((k) + 1)) xcd_barrier(bar); } while (0)

    if (HASP(0) && IN(0)) { REPLOOP(REP_P0) { p0_prologue(F); __syncthreads(); } SEAM(0); }

    bf16* XB = (bf16*)(KARG(F)->ws + WS_XB);
    bf16* PROJ = (bf16*)(KARG(F)->ws + WS_PROJ); bf16* MIXB = (bf16*)(KARG(F)->ws + WS_MIX); bf16* HID = (bf16*)(KARG(F)->ws + WS_HID);
#pragma unroll
    for (int l = 0; l < DEPTH; ++l) {
        const int pb = 1 + 6 * l;
        unsigned char* wl = KARG(F)->ws + WS_W + (size_t)l * W_LAYER;
        if (HASP(1) && IN(pb)) {
            pg8::Gemm g{XB, (const bf16*)(wl + W_IN), M, NPROJ, DMODEL}; pg8::StaticOrder S; S.init(M, NPROJ, F.G, F.bid);
            pg8::EpiProj E{PROJ, NPROJ, (const float*)(KARG(F)->ws + WS_SSQ + (size_t)(2 * l) * SSQ_STRIDE), KARG(F)->in[I_QNG] + l * 64, KARG(F)->in[I_KNG] + l * 64, (const float*)(KARG(F)->ws + WS_ROPE), 1.0f / DMODEL, EPS};
            REPLOOP(REP_P1) pg8::gemm_phase<pg8::EpiProj, pg8::StaticOrder, true, true>(F.lds + RING_OFF, g, S, E);
            SEAM(pb);
        }
        if (HASP(2) && IN(pb + 1)) {
            REPLOOP(REP_G1) {
#pragma unroll 1
            for (int k = 0; k < 3; ++k) { const int u = (F.bid >> 3) + 32 * k;
            if (u < 96) gla_g1_unit(F, l, 24 * (F.bid & 7) + (u >> 2), u & 3);
            } }
            __syncthreads();
            REPLOOP(REP_SG) {
#pragma unroll 1
            for (int k = 0; k < 2; ++k) { const int u = (F.bid >> 3) + 32 * k;
            if (u < 64) sg_unit(F, l, 4 * (F.bid & 7) + (u >> 4), u & 15);
            } }
            REPLOOP(REP_ATT) { att_phase(F, l); }
            SEAM(pb + 1);
        }
        if (HASP(3) && IN(pb + 2)) {
            att_combine(F, l);
            REPLOOP(REP_G2)
#pragma unroll 1
            for (int k = 0; k < 3; ++k) { const int u = (F.bid >> 3) + 32 * k; if (u < 96) gla_g2_unit(F, l, 24 * (F.bid & 7) + (u >> 2), u & 3); }
            SEAM(pb + 2);
        }
        if (HASP(4) && IN(pb + 3)) {
            pg8::Gemm g{MIXB, (const bf16*)(wl + W_OUT), M, DMODEL, DMODEL}; pg8::StaticOrder S; S.init(M, DMODEL, F.G, F.bid);
            pg8::EpiResidB E{XB, (float*)(KARG(F)->ws + WS_SSQ + (size_t)(2 * l + 1) * SSQ_STRIDE), nullptr, DMODEL};
            pg8::gemm_phase<pg8::EpiResidB, pg8::StaticOrder, true, true>(F.lds + RING_OFF, g, S, E);
            SEAM(pb + 3);
        }
        if (HASP(5) && IN(pb + 4)) {
            pg8::Gemm g{XB, (const bf16*)(wl + W_1), M, FF, DMODEL}; pg8::StaticOrder S; S.init(M, FF, F.G, F.bid);
            pg8::EpiScaleBf16<1> E{HID, FF, (const float*)(KARG(F)->ws + WS_SSQ + (size_t)(2 * l + 1) * SSQ_STRIDE), 1.0f / DMODEL, EPS};
            REPLOOP(REP_P4) pg8::gemm_phase<pg8::EpiScaleBf16<1>, pg8::StaticOrder, true, true>(F.lds + RING_OFF, g, S, E);
            SEAM(pb + 4);
        }
        if (HASP(6) && IN(pb + 5)) {
            pg8::Gemm g{HID, (const bf16*)(wl + W_2), M, DMODEL, FF}; pg8::StaticOrder S; S.init(M, DMODEL, F.G, F.bid);
            pg8::EpiResidB E{XB, (float*)(KARG(F)->ws + WS_SSQ + (size_t)((2 * l + 2) & 3) * SSQ_STRIDE), (l + 1 < DEPTH) ? nullptr : KARG(F)->out, DMODEL};
            pg8::gemm_phase<pg8::EpiResidB, pg8::StaticOrder, true, true>(F.lds + RING_OFF, g, S, E);
            if (l + 1 < DEPTH) SEAM(pb + 5);
        }
    }
#undef IN
#undef SEAM
}

extern "C" void kernel_launch(void* const* d_in, const int* in_sizes, int n_in, void* d_out, int out_size, void* d_ws, size_t ws_size, hipStream_t stream) {
    static int grid = 0;
    if (grid == 0) {
        if (n_in != 16 || in_sizes[0] != M * DMODEL || out_size != M * DMODEL || ws_size < WS_END2) { fprintf(stderr, "kernel_launch: unexpected shapes (n_in %d, in0 %d, out %d, ws %zu); nothing launched\n", n_in, n_in > 0 ? in_sizes[0] : -1, out_size, ws_size); grid = -1; return; }
        int dev = 0, cus = 0, per_cu = 0;
        if (hipGetDevice(&dev) != hipSuccess || hipDeviceGetAttribute(&cus, hipDeviceAttributeMultiprocessorCount, dev) != hipSuccess) { grid = -1; return; }
        if (hipFuncSetAttribute((const void*)hybrid_fwd, hipFuncAttributeMaxDynamicSharedMemorySize, LDS_BYTES) != hipSuccess) { fprintf(stderr, "kernel_launch: hipFuncSetAttribute failed\n"); grid = -1; return; }
        if (hipOccupancyMaxActiveBlocksPerMultiprocessor(&per_cu, (const void*)hybrid_fwd, NWAVES * 64, LDS_BYTES) != hipSuccess || per_cu < 1)
            fprintf(stderr, "kernel_launch: note: occupancy query reports %d workgroups per CU\n", per_cu);
        (void)hipGetLastError();
        grid = cus;
        if (grid != 256) fprintf(stderr, "kernel_launch: %d CUs (built for 256)\n", grid);
        if (grid > 256) grid = 256;
        grid &= ~7;
    }
    if (grid <= 0) return;
    if (hipMemsetAsync((char*)d_ws + WS_CTL, 0, CTL_ZERO_BYTES, stream) != hipSuccess) { fprintf(stderr, "kernel_launch: memset failed\n"); return; }
    Args a{};
    for (int i = 0; i < 16; ++i) a.in[i] = (const float*)d_in[i];
    a.out = (float*)d_out; a.ws = (unsigned char*)d_ws;
    int lo_ = 0, li = 0;
    for (int p = 0; p < NPHASE; ++p) {
        const int ty = (p == 0) ? 0 : ((p - 1) % 6) + 1;
        const bool cut = (p == NPHASE - 1) || ((CUTMASK >> ty) & 1);
        if (!cut) continue;
        a.li = li; a.ph_lo = lo_; a.ph_hi = p + 1; lo_ = p + 1;
        hipLaunchKernelGGL(hybrid_fwd, dim3(grid), dim3(NWAVES * 64), LDS_BYTES, stream, a);
        const hipError_t le = hipPeekAtLastError();
        if (le != hipSuccess) { fprintf(stderr, "kernel_launch: launch %d failed: %s\n", li, hipGetErrorName(le)); break; }
        ++li;
    }
}
```

```cpp
#include <hip/hip_runtime.h>
#include <cstdio>
#include <cstdint>
namespace pg8 {
#define PG8_LAS __attribute__((address_space(3)))
typedef unsigned short bf16_t;
typedef short bf16x8 __attribute__((ext_vector_type(8)));
typedef float f32x4 __attribute__((ext_vector_type(4)));
typedef unsigned u32x4 __attribute__((ext_vector_type(4)));
constexpr int BM = 256, BK = 64, HALF = 128, HTB = HALF * BK * 2  , STAGE_BYTES = 8 * HTB, NXCD = 8, WGM = 8;

__host__ __device__ __forceinline__ int lds_byte(int r, int c) { const int st = (r >> 4) * 2 + (c >> 5), rr = r & 15, cc = c & 31, ob = rr * 64 + cc * 2; return st * 1024 + (ob ^ (((ob >> 9) & 1) << 5)); }
__host__ __device__ __forceinline__ void stage_rc(int b, int& R, int& C) { const int st = b / 1024, sb = b % 1024, swz = sb ^ (((sb >> 9) & 1) << 5); R = (st >> 1) * 16 + swz / 64; C = (st & 1) * 32 + (swz % 64) / 2; }
__host__ __device__ __forceinline__ int perm32(int rho) { const int n = rho >> 4, i = rho & 15; return 8 * (i >> 2) + 4 * n + (i & 3); }

struct Unit { int pm, pn; };
struct Gemm { const bf16_t* A; const bf16_t* Bt; int M, N, K; };

struct StaticOrder {
    int nM, nN, nwg, G, c;
    __host__ __device__ void init(int M, int N, int G_, int c_) { nM = M / BM; nN = N / BM; nwg = nM * nN; G = G_; c = c_; }
    __host__ __device__ bool next(int i, Unit& u) const {
        const long L = (long)i * G + c; if (L >= nwg) return false;
        int wgid = (int)L; { const int q = nwg / NXCD, r = nwg % NXCD, xcd = wgid % NXCD, off = wgid / NXCD; wgid = (xcd < r ? xcd * (q + 1) : r * (q + 1) + (xcd - r) * q) + off; }
        const int nig = WGM * nN, gid = wgid / nig, fm = gid * WGM, gsz = (nM - fm) < WGM ? (nM - fm) : WGM;
        u.pm = fm + ((wgid % nig) % gsz); u.pn = (wgid % nig) / gsz; return true;
    }
    __device__ __forceinline__ void a_ready(const Unit&) const {}
    __device__ __forceinline__ void done(const Unit&) const {}
};

typedef float f32x2_t __attribute__((ext_vector_type(2))); typedef __bf16 bf16x2_t __attribute__((ext_vector_type(2)));
__device__ __forceinline__ unsigned cvt_pk_bf16(float lo, float hi) { const f32x2_t v = {lo, hi}; return __builtin_bit_cast(unsigned, __builtin_convertvector(v, bf16x2_t)); }
constexpr int SSQ_M = 65536;
__device__ __forceinline__ float row_rstd(const float* ssq, int row, int fq, float inv_n, float eps) {
    const f32x4 p = *(const f32x4*)(ssq + (size_t)row * 16 + 4 * fq);
    float s = (p[0] + p[1]) + (p[2] + p[3]);
    s += __shfl_xor(s, 16); s += __shfl_xor(s, 32);
    return 1.0f / sqrtf(s * inv_n + eps);
}
template <int ACT> struct EpiScaleBf16 {
    static constexpr bool PERM = true, AFTER_DRAIN = false;
    bf16_t* O; int ldc; const float* ssq; float inv_n, eps;
    __device__ __forceinline__ void operator()(const f32x4 (&acc)[2][2][4][2], const Unit& u, int wr, int wc, int fr, int fq) const {
        const int row0 = u.pm * BM + wr * 64 + fr, col0 = u.pn * BM + wc * 32 + 8 * fq;
#pragma unroll
        for (int ai = 0; ai < 2; ++ai)
#pragma unroll
            for (int m = 0; m < 4; ++m) {
                const int row = row0 + ai * HALF + m * 16;
                const float rs = row_rstd(ssq, row, fq, inv_n, eps);
                bf16_t* rowp = O + (size_t)row * ldc + col0;
#pragma unroll
                for (int bj = 0; bj < 2; ++bj) {
                    f32x4 v0 = acc[ai][bj][m][0] * rs, v1 = acc[ai][bj][m][1] * rs;
                    if (ACT == 1) {
#pragma unroll
                        for (int e = 0; e < 4; ++e) { const float a = fmaxf(v0[e], 0.f), b = fmaxf(v1[e], 0.f); v0[e] = a * a; v1[e] = b * b; }
                    }
                    u32x4 w; w.x = cvt_pk_bf16(v0[0], v0[1]); w.y = cvt_pk_bf16(v0[2], v0[3]); w.z = cvt_pk_bf16(v1[0], v1[1]); w.w = cvt_pk_bf16(v1[2], v1[3]);
                    *(u32x4*)(rowp + bj * HALF) = w;
                }
            }
    }
};
struct EpiProj {
    static constexpr bool PERM = true, AFTER_DRAIN = false;
    bf16_t* O; int ldc; const float* ssq; const float* qg; const float* kg; const float* rope; float inv_n, eps;
    __device__ __forceinline__ void operator()(const f32x4 (&acc)[2][2][4][2], const Unit& u, int wr, int wc, int fr, int fq) const {
        const int row0 = u.pm * BM + wr * 64 + fr, colh = u.pn * BM + wc * 64 + 8 * fq;
        const bool qk = u.pn < 3;
        f32x4 g00 = {1.f, 1.f, 1.f, 1.f}, g01 = g00, g10 = g00, g11 = g00; float sc = 1.f;
        if (qk) { const int hg = 4 * u.pn + wc; const float* g = hg < 6 ? qg : kg; sc = hg < 6 ? 0.125f : 1.0f;
            const int d0 = fq < 2 ? 4 * fq : 8 * fq, d1 = fq < 2 ? 4 * fq + 8 : 8 * fq + 4;
            g00 = *(const f32x4*)(g + d0); g01 = *(const f32x4*)(g + d1); g10 = *(const f32x4*)(g + 32 + 8 * fq); g11 = *(const f32x4*)(g + 36 + 8 * fq); }
#pragma unroll
        for (int ai = 0; ai < 2; ++ai)
#pragma unroll
            for (int m = 0; m < 4; ++m) {
                const int row = row0 + ai * HALF + m * 16;
                const float rs = row_rstd(ssq, row, fq, inv_n, eps);
                f32x4 v00 = acc[ai][0][m][0] * rs, v01 = acc[ai][0][m][1] * rs, v10 = acc[ai][1][m][0] * rs, v11 = acc[ai][1][m][1] * rs;
                if (qk) {
                    float ss = 0.f;
#pragma unroll
                    for (int e = 0; e < 4; ++e) ss += (v00[e] * v00[e] + v01[e] * v01[e]) + (v10[e] * v10[e] + v11[e] * v11[e]);
                    ss += __shfl_xor(ss, 16); ss += __shfl_xor(ss, 32);
                    const float r = sc / sqrtf(ss * (1.0f / 64.0f) + eps);
                    v00 = v00 * (g00 * r); v01 = v01 * (g01 * r); v10 = v10 * (g10 * r); v11 = v11 * (g11 * r);
                    const int t = row & 2047;
                    const f32x4 cs = *(const f32x4*)(rope + t * 16 + 4 * (fq & 1)), sn = *(const f32x4*)(rope + t * 16 + 8 + 4 * (fq & 1));
                    const f32x4 ra = v00 * cs - v01 * sn, rb = v01 * cs + v00 * sn;
                    if (fq < 2) { v00 = ra; v01 = rb; }
                }
                bf16_t* rowp = O + (size_t)row * ldc + colh;
                u32x4 w; w.x = cvt_pk_bf16(v00[0], v00[1]); w.y = cvt_pk_bf16(v00[2], v00[3]); w.z = cvt_pk_bf16(v01[0], v01[1]); w.w = cvt_pk_bf16(v01[2], v01[3]);
                *(u32x4*)(rowp) = w;
                w.x = cvt_pk_bf16(v10[0], v10[1]); w.y = cvt_pk_bf16(v10[2], v10[3]); w.z = cvt_pk_bf16(v11[0], v11[1]); w.w = cvt_pk_bf16(v11[2], v11[3]);
                *(u32x4*)(rowp + 32) = w;
            }
    }
};
struct EpiResidDry {
    static constexpr bool PERM = true, AFTER_DRAIN = false;
    const float* base; bf16_t* xb; int ldc;
    __device__ __forceinline__ void operator()(const f32x4 (&acc)[2][2][4][2], const Unit& u, int wr, int wc, int fr, int fq) const {
        const int row0 = u.pm * BM + wr * 64 + fr, col0 = u.pn * BM + wc * 32 + 8 * fq;
#pragma unroll
        for (int ai = 0; ai < 2; ++ai)
#pragma unroll
            for (int m = 0; m < 4; ++m) {
                const int row = row0 + ai * HALF + m * 16;
                const size_t off = (size_t)row * ldc + col0;
#pragma unroll
                for (int bj = 0; bj < 2; ++bj) {
                    const f32x4 b0 = *(const f32x4*)(base + off + bj * HALF), b1 = *(const f32x4*)(base + off + bj * HALF + 4);
                    const f32x4 v0 = acc[ai][bj][m][0] + b0, v1 = acc[ai][bj][m][1] + b1;
                    u32x4 w; w.x = cvt_pk_bf16(v0[0], v0[1]); w.y = cvt_pk_bf16(v0[2], v0[3]); w.z = cvt_pk_bf16(v1[0], v1[1]); w.w = cvt_pk_bf16(v1[2], v1[3]);
                    *(u32x4*)(xb + off + bj * HALF) = w;
                }
                asm volatile("" ::: "memory");
            }
    }
};
struct EpiResidB {
    static constexpr bool PERM = true, AFTER_DRAIN = false;
    bf16_t* xb; float* ssq; float* outf; int ldc;
    __device__ __forceinline__ void operator()(const f32x4 (&acc)[2][2][4][2], const Unit& u, int wr, int wc, int fr, int fq) const {
        const int row0 = u.pm * BM + wr * 64 + fr, col0 = u.pn * BM + wc * 32 + 8 * fq;
#pragma unroll
        for (int ai = 0; ai < 2; ++ai)
#pragma unroll
            for (int m = 0; m < 4; ++m) {
                const int row = row0 + ai * HALF + m * 16;
                const size_t off = (size_t)row * ldc + col0;
                float s = 0.f;
#pragma unroll
                for (int bj = 0; bj < 2; ++bj) {
                    const u32x4 xo = *(const u32x4*)(xb + off + bj * HALF);
                    const f32x4 b0 = {__uint_as_float(xo.x << 16), __uint_as_float(xo.x & 0xffff0000u), __uint_as_float(xo.y << 16), __uint_as_float(xo.y & 0xffff0000u)};
                    const f32x4 b1 = {__uint_as_float(xo.z << 16), __uint_as_float(xo.z & 0xffff0000u), __uint_as_float(xo.w << 16), __uint_as_float(xo.w & 0xffff0000u)};
                    const f32x4 v0 = acc[ai][bj][m][0] + b0, v1 = acc[ai][bj][m][1] + b1;
                    if (outf) { *(f32x4*)(outf + off + bj * HALF) = v0; *(f32x4*)(outf + off + bj * HALF + 4) = v1; }
                    else {
                        u32x4 w; w.x = cvt_pk_bf16(v0[0], v0[1]); w.y = cvt_pk_bf16(v0[2], v0[3]); w.z = cvt_pk_bf16(v1[0], v1[1]); w.w = cvt_pk_bf16(v1[2], v1[3]);
                        *(u32x4*)(xb + off + bj * HALF) = w;
                        s += (v0[0] * v0[0] + v0[1] * v0[1]) + (v0[2] * v0[2] + v0[3] * v0[3]) + (v1[0] * v1[0] + v1[1] * v1[1]) + (v1[2] * v1[2] + v1[3] * v1[3]); }
                }
                if (!outf) { s += __shfl_xor(s, 16); s += __shfl_xor(s, 32);
                    if (fq == 0) ssq[(size_t)row * 16 + 4 * u.pn + wc] = s; }
                asm volatile("" ::: "memory");
            }
    }
};
struct EpiResid {
    static constexpr bool PERM = true, AFTER_DRAIN = false;
    const float* base; float* out; bf16_t* xb; float* ssq; int ldc;
    __device__ __forceinline__ void operator()(const f32x4 (&acc)[2][2][4][2], const Unit& u, int wr, int wc, int fr, int fq) const {
        const int row0 = u.pm * BM + wr * 64 + fr, col0 = u.pn * BM + wc * 32 + 8 * fq;
#pragma unroll
        for (int ai = 0; ai < 2; ++ai)
#pragma unroll
            for (int m = 0; m < 4; ++m) {
                const int row = row0 + ai * HALF + m * 16;
                const size_t off = (size_t)row * ldc + col0;
                float s = 0.f;
#pragma unroll
                for (int bj = 0; bj < 2; ++bj) {
                    const f32x4 b0 = *(const f32x4*)(base + off + bj * HALF), b1 = *(const f32x4*)(base + off + bj * HALF + 4);
                    const f32x4 v0 = acc[ai][bj][m][0] + b0, v1 = acc[ai][bj][m][1] + b1;
                    *(f32x4*)(out + off + bj * HALF) = v0; *(f32x4*)(out + off + bj * HALF + 4) = v1;
                    u32x4 w; w.x = cvt_pk_bf16(v0[0], v0[1]); w.y = cvt_pk_bf16(v0[2], v0[3]); w.z = cvt_pk_bf16(v1[0], v1[1]); w.w = cvt_pk_bf16(v1[2], v1[3]);
                    *(u32x4*)(xb + off + bj * HALF) = w;
                    s += (v0[0] * v0[0] + v0[1] * v0[1]) + (v0[2] * v0[2] + v0[3] * v0[3]) + (v1[0] * v1[0] + v1[1] * v1[1]) + (v1[2] * v1[2] + v1[3] * v1[3]);
                }
                s += __shfl_xor(s, 16); s += __shfl_xor(s, 32);
                if (fq == 0) ssq[((size_t)u.pn * SSQ_M + row) * 4 + wc] = s;
                asm volatile("" ::: "memory");
            }
    }
};
template <class Epi, class Sched, bool ALIGN_EPI = false, bool SP2 = false>
__device__ __forceinline__ void gemm_phase(PG8_LAS unsigned char* lds, const Gemm g, const Sched& S, const Epi& E) {
    int tid = threadIdx.x; asm volatile("" : "+v"(tid));
    const int wid = __builtin_amdgcn_readfirstlane(tid >> 6), lane = tid & 63, wr = wid >> 2, wc = wid & 3, fr = lane & 15, fq = lane >> 4;
    const int K = g.K, nt = K / BK;
    unsigned voffA[2], voffB[2];
#pragma unroll
    for (int i = 0; i < 2; ++i) { int R, C; stage_rc(tid * 16 + i * 8192, R, C); const int Rb = Epi::PERM ? ((R & ~31) + perm32(R & 31)) : R;
        voffA[i] = (unsigned)(R * K + C) * 2u; voffB[i] = (unsigned)(Rb * K + C) * 2u; }
    const size_t kstep = (size_t)(BK * 2);
    const size_t hstep = (size_t)HALF * K * 2;
    const size_t tstep = 2 * hstep;
    const unsigned ldsw = (unsigned)wid * 1024u;
    const int aoff = lds_byte(wr * 64 + fr, fq * 8), boff = lds_byte(wc * 32 + fr, fq * 8);
#define PG8_SA(b, h) (((b) * 2 + (h)) * HTB)
#define PG8_SB(b, h) ((4 + (b) * 2 + (h)) * HTB)
#define PG8_STAGE(bufoff, gbase, voff) do { _Pragma("unroll") for (int _i = 0; _i < 2; ++_i) \
        __builtin_amdgcn_global_load_lds((const unsigned*)((const char*)(gbase) + (voff)[_i]), (PG8_LAS unsigned*)(lds + (bufoff) + ldsw + _i * 8192), 16, 0, 0); } while (0)
#define PG8_LDA(dst, b, h) do { _Pragma("unroll") for (int m = 0; m < 4; ++m) _Pragma("unroll") for (int k = 0; k < 2; ++k) dst[m][k] = *(const PG8_LAS bf16x8*)(lds + PG8_SA(b, h) + aoff + m * 2048 + k * 1024); } while (0)
#define PG8_LDB(dst, b, h) do { _Pragma("unroll") for (int n = 0; n < 2; ++n) _Pragma("unroll") for (int k = 0; k < 2; ++k) dst[n][k] = *(const PG8_LAS bf16x8*)(lds + PG8_SB(b, h) + boff + n * 2048 + k * 1024); } while (0)
#define PG8_MMA(ai, bj, At, Bt) do { __builtin_amdgcn_s_setprio(1); _Pragma("unroll") for (int m = 0; m < 4; ++m) _Pragma("unroll") for (int n = 0; n < 2; ++n) _Pragma("unroll") for (int k = 0; k < 2; ++k) \
        acc[ai][bj][m][n] = __builtin_amdgcn_mfma_f32_16x16x32_bf16(Bt[n][k], At[m][k], acc[ai][bj][m][n], 0, 0, 0); __builtin_amdgcn_s_setprio(0); } while (0)
#define PG8_WAIT_V(n) asm volatile("s_waitcnt vmcnt(" #n ")" ::: "memory")
#define PG8_WAIT_L(n) asm volatile("s_waitcnt lgkmcnt(" #n ")" ::: "memory")
#define PG8_BAR __builtin_amdgcn_s_barrier()
#define PG8_SCHED __builtin_amdgcn_sched_barrier(0)
    Unit cur, nxt; int ui = 0;
    if (!S.next(0, cur)) return;
    f32x4 acc[2][2][4][2];
#pragma unroll
    for (int a = 0; a < 2; ++a)
#pragma unroll
        for (int b = 0; b < 2; ++b)
#pragma unroll
            for (int m = 0; m < 4; ++m)
#pragma unroll
                for (int n = 0; n < 2; ++n) acc[a][b][m][n] = (f32x4){0.f, 0.f, 0.f, 0.f};
    bf16x8 At[4][2], B0[2][2], B1[2][2];
    const char* cA = (const char*)g.A + (size_t)cur.pm * tstep; const char* cB = (const char*)g.Bt + (size_t)cur.pn * tstep;
    S.a_ready(cur);
    if constexpr (SP2) {
        PG8_STAGE(PG8_SB(0, 0), cB, voffB); PG8_STAGE(PG8_SB(0, 1), cB + hstep, voffB); PG8_STAGE(PG8_SA(0, 0), cA, voffA); PG8_STAGE(PG8_SA(0, 1), cA + hstep, voffA);
        if (wr == 1) PG8_BAR;
        PG8_WAIT_V(2); PG8_BAR;
        PG8_STAGE(PG8_SB(1, 0), cB + kstep, voffB); PG8_STAGE(PG8_SA(1, 0), cA + kstep, voffA); PG8_STAGE(PG8_SB(1, 1), cB + hstep + kstep, voffB);
        PG8_WAIT_V(6); PG8_BAR;
    } else {
        PG8_STAGE(PG8_SB(0, 0), cB, voffB); PG8_STAGE(PG8_SA(0, 0), cA, voffA); PG8_STAGE(PG8_SB(0, 1), cB + hstep, voffB); PG8_STAGE(PG8_SA(0, 1), cA + hstep, voffA);
        if (wr == 1) PG8_BAR;
        PG8_WAIT_V(4); PG8_BAR;
        PG8_STAGE(PG8_SB(1, 0), cB + kstep, voffB); PG8_STAGE(PG8_SA(1, 0), cA + kstep, voffA); PG8_STAGE(PG8_SB(1, 1), cB + hstep + kstep, voffB);
        PG8_WAIT_V(6); PG8_BAR;
    }
    for (;;) {
        const bool has_next = S.next(ui + 1, nxt);
        const char* nA = has_next ? (const char*)g.A + (size_t)nxt.pm * tstep : cA; const char* nB = has_next ? (const char*)g.Bt + (size_t)nxt.pn * tstep : cB;
        for (int t = 0; t < nt; t += 2) {
            const bool last = (t == nt - 2);
            const char* a1 = cA + (size_t)(t + 1) * kstep;
            const char* a2 = last ? nA : cA + (size_t)(t + 2) * kstep; const char* b2 = last ? nB : cB + (size_t)(t + 2) * kstep;
            const char* a3 = a2 + kstep; const char* b3 = b2 + kstep;
            if (last && has_next) S.a_ready(nxt);
            if constexpr (SP2) {
            PG8_LDB(B0, 0, 0); PG8_LDB(B1, 0, 1); PG8_SCHED; PG8_LDA(At, 0, 0); PG8_STAGE(PG8_SA(1, 1), a1 + hstep, voffA);
            PG8_WAIT_V(8); PG8_WAIT_L(0); PG8_BAR; PG8_MMA(0, 0, At, B0); PG8_MMA(0, 1, At, B1); PG8_BAR; PG8_SCHED;
            PG8_LDA(At, 0, 1); PG8_STAGE(PG8_SB(0, 0), b2, voffB); PG8_STAGE(PG8_SB(0, 1), b2 + hstep, voffB); PG8_STAGE(PG8_SA(0, 0), a2, voffA);
            PG8_WAIT_V(8); PG8_WAIT_L(0); PG8_BAR; PG8_MMA(1, 0, At, B0); PG8_MMA(1, 1, At, B1); PG8_BAR; PG8_SCHED;
            PG8_LDB(B0, 1, 0); PG8_LDB(B1, 1, 1); PG8_SCHED; PG8_LDA(At, 1, 0); PG8_STAGE(PG8_SA(0, 1), a2 + hstep, voffA);
            PG8_WAIT_V(8); PG8_WAIT_L(0); PG8_BAR; PG8_MMA(0, 0, At, B0); PG8_MMA(0, 1, At, B1); PG8_BAR; PG8_SCHED;
            PG8_LDA(At, 1, 1); PG8_STAGE(PG8_SB(1, 0), b3, voffB); PG8_STAGE(PG8_SB(1, 1), b3 + hstep, voffB); PG8_STAGE(PG8_SA(1, 0), a3, voffA);
            PG8_WAIT_V(8); PG8_WAIT_L(0); PG8_BAR; PG8_MMA(1, 0, At, B0); PG8_MMA(1, 1, At, B1); PG8_BAR; PG8_SCHED;
            } else {
            PG8_LDB(B0, 0, 0); PG8_SCHED; PG8_LDA(At, 0, 0); PG8_STAGE(PG8_SA(1, 1), a1 + hstep, voffA);
            PG8_WAIT_L(8); PG8_BAR; PG8_WAIT_L(0); PG8_MMA(0, 0, At, B0); PG8_BAR; PG8_SCHED;
            PG8_LDB(B1, 0, 1); PG8_STAGE(PG8_SB(0, 0), b2, voffB);
            PG8_BAR; PG8_WAIT_L(0); PG8_MMA(0, 1, At, B1); PG8_BAR;
            PG8_LDA(At, 0, 1); PG8_STAGE(PG8_SA(0, 0), a2, voffA);
            PG8_BAR; PG8_WAIT_L(0); PG8_MMA(1, 0, At, B0); PG8_BAR; PG8_SCHED;
            PG8_STAGE(PG8_SB(0, 1), b2 + hstep, voffB);
            PG8_WAIT_V(6); PG8_BAR; PG8_MMA(1, 1, At, B1); PG8_BAR;
            PG8_LDB(B0, 1, 0); PG8_SCHED; PG8_LDA(At, 1, 0); PG8_STAGE(PG8_SA(0, 1), a2 + hstep, voffA);
            PG8_WAIT_L(8); PG8_BAR; PG8_WAIT_L(0); PG8_MMA(0, 0, At, B0); PG8_BAR; PG8_SCHED;
            PG8_LDB(B1, 1, 1); PG8_STAGE(PG8_SB(1, 0), b3, voffB);
            PG8_BAR; PG8_WAIT_L(0); PG8_MMA(0, 1, At, B1); PG8_BAR;
            PG8_LDA(At, 1, 1); PG8_STAGE(PG8_SA(1, 0), a3, voffA);
            PG8_BAR; PG8_WAIT_L(0); PG8_MMA(1, 0, At, B0); PG8_BAR; PG8_SCHED;
            PG8_STAGE(PG8_SB(1, 1), b3 + hstep, voffB);
            PG8_WAIT_V(6); PG8_BAR; PG8_MMA(1, 1, At, B1); PG8_BAR;
            }
        }
        if constexpr (ALIGN_EPI) { if (wr == 0) PG8_BAR; }
        if constexpr (!Epi::AFTER_DRAIN) { E(acc, cur, wr, wc, fr, fq); S.done(cur); }
        if (!has_next) break;
#pragma unroll
        for (int a = 0; a < 2; ++a)
#pragma unroll
            for (int b = 0; b < 2; ++b)
#pragma unroll
                for (int m = 0; m < 4; ++m)
#pragma unroll
                    for (int n = 0; n < 2; ++n) acc[a][b][m][n] = (f32x4){0.f, 0.f, 0.f, 0.f};
        cur = nxt; cA = nA; cB = nB; ++ui;
        if constexpr (ALIGN_EPI) { if (wr == 1) PG8_BAR; }
    }
    PG8_WAIT_V(0);
    if constexpr (!ALIGN_EPI) { if (wr == 0) PG8_BAR; }
    PG8_BAR;
    if constexpr (Epi::AFTER_DRAIN) { E.fused(acc, cur, wr, wc, fr, fq, lds, wid, lane); S.done(cur); }
#undef PG8_SA
#undef PG8_SB
#undef PG8_STAGE
#undef PG8_LDA
#undef PG8_LDB
#undef PG8_MMA
#undef PG8_WAIT_V
#undef PG8_WAIT_L
#undef PG8_BAR
#undef PG8_SCHED
}
}
constexpr int NWAVES = 8;
constexpr int BATCH = 32, SEQ = 2048, DMODEL = 1024, DEPTH = 2, FF = 4096;
constexpr int M = BATCH * SEQ;
constexpr int NPROJ = 3072, IN_DIM = 2832;
constexpr int QA = 0, KA = 384, VA = 768, QG = 1152, KG = 1344, VG = 1536, RG = 1920, ZS = 2304, AG = 2816;
constexpr float EPS = 1e-6f;
constexpr int NPHASE = 1 + 6 * DEPTH;
#ifndef MK_N_LAUNCHES
#define MK_N_LAUNCHES 1
#endif
#ifndef CUTMASK
#define CUTMASK 0
#endif
constexpr int N_LAUNCHES = MK_N_LAUNCHES;

constexpr size_t MiB = 1u << 20;
constexpr size_t WS_CTL = 0, CTL_ZERO_BYTES = 1 * MiB;
constexpr size_t WS_ROPE = 1 * MiB;
constexpr size_t WS_WSG = 1 * MiB + 256 * 1024;
constexpr size_t WS_W = 2 * MiB, W_LAYER = 24 * MiB;
constexpr size_t W_IN = 0, W_OUT = 6 * MiB, W_1 = 8 * MiB, W_2 = 16 * MiB;
constexpr size_t WS_SSQ = 50 * MiB, SSQ_STRIDE = 4 * MiB;
constexpr size_t WS_XB = 66 * MiB;
constexpr size_t WS_BC = 194 * MiB, WS_KVS = 242 * MiB;
constexpr size_t WS_DEC = 290 * MiB, DEC_STRIDE = 1 * MiB;
constexpr size_t WS_AGS = 292 * MiB, AGS_STRIDE = 6 * MiB, WS_AGD = 304 * MiB, AGD_STRIDE = 512 * 1024;
constexpr size_t WS_LSE = 305 * MiB, LSE_STRIDE = 5 * MiB;
constexpr size_t WS_PROJ = 320 * MiB, WS_MIX = 704 * MiB, WS_HID = 320 * MiB, WS_END = 832 * MiB;
constexpr size_t WS_OR = 832 * MiB, WS_END2 = WS_OR + (size_t)3 * 65536 * 384 * 2;
static_assert(WS_W + DEPTH * W_LAYER <= WS_SSQ && WS_SSQ + 4 * SSQ_STRIDE <= WS_XB && WS_XB + (size_t)M * DMODEL * 2 <= WS_BC && WS_BC + (size_t)6144 * 2048 * 4 <= WS_KVS && WS_KVS + (size_t)6144 * 2048 * 4 <= WS_DEC, "ws map");
static_assert(WS_DEC + DEPTH * DEC_STRIDE <= WS_AGS && WS_AGS + DEPTH * AGS_STRIDE <= WS_AGD && WS_AGD + DEPTH * AGD_STRIDE <= WS_LSE && WS_LSE + DEPTH * LSE_STRIDE <= WS_PROJ && (size_t)3 * 192 * 2048 * 4 <= LSE_STRIDE, "ws map");
static_assert(WS_PROJ + (size_t)M * NPROJ * 2 <= WS_MIX && WS_MIX + (size_t)M * DMODEL * 2 <= WS_END && WS_HID + (size_t)M * FF * 2 <= WS_END && WS_END2 <= 1024 * MiB, "ws map");
constexpr int CW_BAR = 4096;

constexpr int RING_OFF = 0, RING_BYTES = 131072;
constexpr int LDSCTL_OFF = RING_BYTES, MISC_OFF = LDSCTL_OFF + 320;
constexpr int LDS_BYTES = 147456;

#define GAS __attribute__((address_space(1)))
#define LAS __attribute__((address_space(3)))
typedef unsigned short bf16;
typedef unsigned v4u __attribute__((ext_vector_type(4)));
typedef unsigned v2u __attribute__((ext_vector_type(2)));
typedef float f32x4 __attribute__((ext_vector_type(4)));
typedef float f32x16 __attribute__((ext_vector_type(16)));
typedef short bf16x8 __attribute__((ext_vector_type(8)));
typedef short s16x4 __attribute__((ext_vector_type(4)));
typedef GAS unsigned gu32;
#define LDS_WAIT() asm volatile("s_waitcnt lgkmcnt(0)" ::: "memory")
#define VM_WAIT() asm volatile("s_waitcnt vmcnt(0)" ::: "memory")
__device__ __forceinline__ unsigned pk2(float lo, float hi) { return pg8::cvt_pk_bf16(lo, hi); }
__device__ __forceinline__ float bflo(unsigned w) { return __uint_as_float(w << 16); }
__device__ __forceinline__ float bfhi(unsigned w) { return __uint_as_float(w & 0xffff0000u); }
__device__ __forceinline__ float bf1(unsigned short h) { return __uint_as_float((unsigned)h << 16); }
__device__ __forceinline__ void unpack8(const v4u w, float* f) { f[0] = bflo(w.x); f[1] = bfhi(w.x); f[2] = bflo(w.y); f[3] = bfhi(w.y); f[4] = bflo(w.z); f[5] = bfhi(w.z); f[6] = bflo(w.w); f[7] = bfhi(w.w); }
__device__ __forceinline__ bf16x8 as_frag(const v4u w) { return __builtin_bit_cast(bf16x8, w); }
__device__ __forceinline__ bf16x8 tr_frag(const LAS unsigned char* p_lo, const LAS unsigned char* p_hi) {
    const s16x4 lo = __builtin_amdgcn_ds_read_tr16_b64_v4i16((LAS s16x4*)p_lo), hi = __builtin_amdgcn_ds_read_tr16_b64_v4i16((LAS s16x4*)p_hi);
    return (bf16x8){lo[0], lo[1], lo[2], lo[3], hi[0], hi[1], hi[2], hi[3]};
}
__device__ __forceinline__ int tr_lane_off(int lane) { return ((lane >> 4) & 1) * 32 + (lane & 3) * 8 + ((lane & 15) >> 2) * 64; }
#define MFMA32(a, b, c) __builtin_amdgcn_mfma_f32_32x32x16_bf16((a), (b), (c), 0, 0, 0)
__device__ __forceinline__ int crow(int r, int hi) { return (r & 3) + 8 * (r >> 2) + 4 * hi; }
__device__ __forceinline__ float wave_sum(float v) {
#pragma unroll
    for (int o = 1; o < 64; o <<= 1) v += __shfl_xor(v, o);
    return v;
}
#define XB_TMO      128
#define XB_XCNT(j)  (256  + 64 * (j))
#define XB_XSUB(j)  (1280 + 64 * (j))
#define XB_XGEN(j)  (2304 + 64 * (j))
#define XB_TOP      3328
#define XB_TOPGEN   3392
#define XCD_BAR_WORDS 3456
#define XB_SPIN_CAP (1u << 18)

__device__ __forceinline__ unsigned xb_ld(unsigned* p)              { return __hip_atomic_load(p, __ATOMIC_RELAXED, __HIP_MEMORY_SCOPE_AGENT); }
__device__ __forceinline__ unsigned xb_add(unsigned* p, unsigned v) { return __hip_atomic_fetch_add(p, v, __ATOMIC_RELAXED, __HIP_MEMORY_SCOPE_AGENT); }
__device__ __forceinline__ unsigned xb_xcc_id() { return (unsigned)__builtin_amdgcn_s_getreg((3 << 11) | 20) & 0xFu; }
#define XB_SPIN(cond, bar) do { unsigned _sp = 0; while (cond) { __builtin_amdgcn_s_sleep(1); \
    if ((++_sp & 255u) == 0u) { if (xb_ld(&(bar)[XB_TMO])) break; if (_sp > XB_SPIN_CAP) { atomicAdd(&(bar)[XB_TMO], 1u); break; } } } } while (0)

struct XcdBarrier {
    unsigned* bar; unsigned x;
    volatile LAS unsigned* st;
};

__device__ __forceinline__ XcdBarrier xcd_barrier_post(unsigned* bar, volatile LAS unsigned* st) {
    XcdBarrier b; b.bar = bar; b.x = xb_xcc_id(); b.st = st;
    if (threadIdx.x == 0) (void)xb_add(&bar[XB_XCNT(b.x)], 1u);
    return b;
}
__device__ __forceinline__ void xcd_barrier_complete(unsigned* bar, unsigned x, unsigned& nloc, unsigned& nx) {
    const unsigned G = gridDim.x * gridDim.y * gridDim.z;
    unsigned sum, cnt, mine, sp = 0u;
    for (;;) {
        sum = 0u; cnt = 0u; mine = 0u;
#pragma unroll
        for (unsigned j = 0; j < 16; ++j) { const unsigned c = xb_ld(&bar[XB_XCNT(j)]); sum += c; cnt += (c > 0u) ? 1u : 0u; mine = (j == x) ? c : mine; }
        if (sum == G) break;
        __builtin_amdgcn_s_sleep(1);
        if ((++sp & 255u) == 0u) { if (xb_ld(&bar[XB_TMO])) break; if (sp > XB_SPIN_CAP) { atomicAdd(&bar[XB_TMO], 1u); break; } }
    }
    nloc = mine > 0u ? mine : 1u; nx = cnt > 0u ? cnt : 1u;
}

__device__ __forceinline__ void xcd_barrier(const XcdBarrier& b) {
    asm volatile("s_waitcnt vmcnt(0)" ::: "memory");
    __syncthreads();
    if (threadIdx.x == 0) {
        unsigned* bar = b.bar;
        __builtin_amdgcn_s_waitcnt(0);
        unsigned nloc = b.st[0], nx = b.st[1];
        if (nloc == 0u) { xcd_barrier_complete(bar, b.x, nloc, nx); b.st[0] = nloc; b.st[1] = nx; }
        const unsigned old = xb_add(&bar[XB_XSUB(b.x)], 1u);
        const unsigned gen = old / nloc;
        if (old + 1u == (gen + 1u) * nloc) {
            __builtin_amdgcn_fence(__ATOMIC_RELEASE, "agent");
            asm volatile("s_waitcnt vmcnt(0)" ::: "memory");
            const unsigned og = xb_add(&bar[XB_TOP], 1u);
            const unsigned tg = og / nx;
            if (og + 1u == (tg + 1u) * nx) xb_add(&bar[XB_TOPGEN], 1u);
            else XB_SPIN(xb_ld(&bar[XB_TOPGEN]) == tg, bar);
            __builtin_amdgcn_fence(__ATOMIC_ACQUIRE, "agent");
            xb_add(&bar[XB_XGEN(b.x)], 1u);
            asm volatile("s_waitcnt vmcnt(0)" ::: "memory");
        } else {
            XB_SPIN(xb_ld(&bar[XB_XGEN(b.x)]) == gen, bar);
            __builtin_amdgcn_fence(__ATOMIC_ACQUIRE, "agent");
            asm volatile("s_waitcnt vmcnt(0)" ::: "memory");
        }
    }
    __syncthreads();
}
struct Args { const float* in[16]; float* out; unsigned char* ws; int ph_lo, ph_hi, li, pad; };
#define CAS __attribute__((address_space(4)))
struct Frame {
    const CAS Args* K;
    LAS unsigned char* lds;
    volatile LAS unsigned* MISC;
    gu32* ctl;
    int tid, lane, wave, G, bid;
};
__device__ __forceinline__ const CAS Args* KARG(const Frame& F) { const CAS Args* a = F.K; asm volatile("" : "+s"(a)); return a; }
enum { I_X = 0, I_N1G, I_WIN, I_QNG, I_KNG, I_WA2, I_BA, I_GNG, I_LNG, I_LNB, I_SGW, I_SGB, I_WOUT, I_N2G, I_W1, I_W2 };

__device__ __forceinline__ float gelu_tanh(float x) {
    const float u = 0.7978845608028654f * (x + 0.044715f * x * x * x);
    return x / (1.0f + __expf(-2.0f * u));
}
__device__ __forceinline__ float log_sigmoid(float x) { return fminf(x, 0.f) - log1pf(__expf(-fabsf(x))); }

template <int MODE>
__device__ __forceinline__ void p0_transpose_item(const float* W, int K, int Nsrc, int Ndst, const float* g, bf16* WT, LAS float* scr, int item, int lane) {
    const int nblk = Ndst / 32, kb = item / nblk, nb = item % nblk, k0 = 64 * kb, n0 = 32 * nb;
    const int nn = n0 + (lane & 31);
    int src = nn;
    if (MODE == 1) {
        const int pn = nn >> 8, ct = nn & 255, wcq = (ct >> 5) & 3, sg = 32 * (ct >> 7) + (ct & 31);
        const int dm = (pn < 3 && sg < 16) ? (4 * (sg >> 3) + (sg & 3) + 8 * ((sg >> 2) & 1)) : sg;
        const int nat = 256 * pn + 64 * wcq + dm;
        src = nat < 2304 ? nat : (nat < 2816 ? nat + 16 : (nat < 2832 ? nat - 512 : -1)); }
#pragma unroll 8
    for (int i = 0; i < 32; ++i) { const int kk = 2 * i + (lane >> 5);
        float v = 0.f; if (src >= 0) { v = W[(size_t)(k0 + kk) * Nsrc + src]; if (g) v *= g[k0 + kk]; }
        scr[kk * 33 + (lane & 31)] = v; }
    LDS_WAIT(); asm volatile("" ::: "memory");
    const int c = lane & 7;
#pragma unroll
    for (int j = 0; j < 4; ++j) { const int n = (lane >> 3) + 8 * j; const LAS float* s = scr + (8 * c) * 33 + n;
        v4u o; o.x = pk2(s[0 * 33], s[1 * 33]); o.y = pk2(s[2 * 33], s[3 * 33]); o.z = pk2(s[4 * 33], s[5 * 33]); o.w = pk2(s[6 * 33], s[7 * 33]);
        *(GAS v4u*)(WT + (size_t)(n0 + n) * K + k0 + 8 * c) = o; }
    LDS_WAIT(); asm volatile("" ::: "memory");
}
__device__ __forceinline__ void p0_prologue(Frame& F) {
    LAS float* scr = (LAS float*)(F.lds + RING_OFF + F.wave * 16384);
    const int gw = F.bid * NWAVES + F.wave, NGW = F.G * NWAVES;
    constexpr int I_IN = 16 * 96, I_OUT = 16 * 32, I_1 = 16 * 128, I_2 = 64 * 32, I_L = I_IN + I_OUT + I_1 + I_2;
    for (int it = gw; it < DEPTH * I_L; it += NGW) {
        const int l = it / I_L; int r = it % I_L;
        unsigned char* wl = KARG(F)->ws + WS_W + (size_t)l * W_LAYER;
        if (r < I_IN) { p0_transpose_item<1>(KARG(F)->in[I_WIN] + (size_t)l * DMODEL * IN_DIM, DMODEL, IN_DIM, NPROJ, KARG(F)->in[I_N1G] + l * DMODEL, (bf16*)(wl + W_IN), scr, r, F.lane); continue; } r -= I_IN;
        if (r < I_OUT) { p0_transpose_item<0>(KARG(F)->in[I_WOUT] + (size_t)l * DMODEL * DMODEL, DMODEL, DMODEL, DMODEL, nullptr, (bf16*)(wl + W_OUT), scr, r, F.lane); continue; } r -= I_OUT;
        if (r < I_1) { p0_transpose_item<0>(KARG(F)->in[I_W1] + (size_t)l * DMODEL * FF, DMODEL, FF, FF, KARG(F)->in[I_N2G] + l * DMODEL, (bf16*)(wl + W_1), scr, r, F.lane); continue; } r -= I_1;
        p0_transpose_item<0>(KARG(F)->in[I_W2] + (size_t)l * FF * DMODEL, FF, DMODEL, DMODEL, nullptr, (bf16*)(wl + W_2), scr, r, F.lane);
    }
    {
        bf16* XB = (bf16*)(KARG(F)->ws + WS_XB); float* SSQ = (float*)(KARG(F)->ws + WS_SSQ);
        for (int ml = (F.bid >> 3) * NWAVES + F.wave; ml < 8192; ml += 32 * NWAVES) { const int m = (F.bid & 7) * 8192 + ml;
            const GAS f32x4* xr = (const GAS f32x4*)(KARG(F)->in[I_X] + (size_t)m * DMODEL) + F.lane;
            f32x4 v[4]; float s = 0.f;
#pragma unroll
            for (int j = 0; j < 4; ++j) { v[j] = xr[64 * j]; s += (v[j].x * v[j].x + v[j].y * v[j].y) + (v[j].z * v[j].z + v[j].w * v[j].w); }
            s = wave_sum(s);
            GAS v2u* o8 = (GAS v2u*)(XB + (size_t)m * DMODEL) + F.lane;
#pragma unroll
            for (int j = 0; j < 4; ++j) { v2u w; w.x = pk2(v[j].x, v[j].y); w.y = pk2(v[j].z, v[j].w); o8[64 * j] = w; }
            if (F.lane < 16) SSQ[(size_t)m * 16 + F.lane] = (F.lane == 0) ? s : 0.f;
        }
    }
    const int gt = F.bid * (NWAVES * 64) + F.tid, NT = F.G * NWAVES * 64;
    {
        float* ROPE = (float*)(KARG(F)->ws + WS_ROPE);
        for (int idx = gt; idx < SEQ * 8; idx += NT) { const int t = idx >> 3, i = idx & 7;
            const float inv = powf(500000.0f, -(float)i * 0.125f); const float ang = (float)t * inv;
            float sn, cs; sincosf(ang, &sn, &cs); ROPE[t * 16 + i] = cs; ROPE[t * 16 + 8 + i] = sn; }
    }
    {
        bf16* WSG = (bf16*)(KARG(F)->ws + WS_WSG); const float* sw = KARG(F)->in[I_SGW];
        for (int idx = gt; idx < DEPTH * 4 * 128 * 128 / 2; idx += NT) { const int e = 2 * idx, t = (e >> 7) & 127, s = e & 127;
            const float a = (s <= t) ? sw[e] : 0.f, b = (s + 1 <= t) ? sw[e + 1] : 0.f; ((GAS unsigned*)WSG)[idx] = pk2(a, b); }
    }
}

__device__ __forceinline__ void qknorm_all(Frame& F, int l) {
    bf16* P = (bf16*)(KARG(F)->ws + WS_PROJ); const float* ROPE = (const float*)(KARG(F)->ws + WS_ROPE);
    const int gt = F.bid * (NWAVES * 64) + F.tid, NT = F.G * NWAVES * 64;
    for (int p = gt; p < M * 12; p += NT) {
        const int row = p / 12, slot = p - row * 12;
        bf16* ptr = P + (size_t)row * NPROJ + slot * 64;
        const float* g = (slot < 6 ? KARG(F)->in[I_QNG] : KARG(F)->in[I_KNG]) + l * 64;
        float x[64]; float ss = 0.f;
#pragma unroll
        for (int c = 0; c < 8; ++c) { const v4u w = *(const GAS v4u*)(ptr + 8 * c); unpack8(w, x + 8 * c); }
#pragma unroll
        for (int d = 0; d < 64; ++d) ss += x[d] * x[d];
        const float r = 1.0f / sqrtf(ss * (1.0f / 64.0f) + EPS);
#pragma unroll
        for (int c = 0; c < 16; ++c) { const f32x4 gv = *(const f32x4*)(g + 4 * c); x[4 * c] *= r * gv[0]; x[4 * c + 1] *= r * gv[1]; x[4 * c + 2] *= r * gv[2]; x[4 * c + 3] *= r * gv[3]; }
        const int t = row & (SEQ - 1);
        const f32x4 c0 = *(const f32x4*)(ROPE + t * 16), c1 = *(const f32x4*)(ROPE + t * 16 + 4), s0 = *(const f32x4*)(ROPE + t * 16 + 8), s1 = *(const f32x4*)(ROPE + t * 16 + 12);
#pragma unroll
        for (int i = 0; i < 8; ++i) { const float cs = i < 4 ? c0[i & 3] : c1[i & 3], sn = i < 4 ? s0[i & 3] : s1[i & 3]; const float a = x[i], b = x[i + 8]; x[i] = a * cs - b * sn; x[i + 8] = b * cs + a * sn; }
        const float sc = slot < 6 ? 0.125f : 1.0f;
#pragma unroll
        for (int c = 0; c < 8; ++c) { v4u w; w.x = pk2(x[8 * c] * sc, x[8 * c + 1] * sc); w.y = pk2(x[8 * c + 2] * sc, x[8 * c + 3] * sc); w.z = pk2(x[8 * c + 4] * sc, x[8 * c + 5] * sc); w.w = pk2(x[8 * c + 6] * sc, x[8 * c + 7] * sc);
            *(GAS v4u*)(ptr + 8 * c) = w; }
    }
}
__device__ __forceinline__ void stage_v64(const bf16* src, LAS unsigned char* vl, int lane) {
#pragma unroll
    for (int c = 0; c < 8; ++c) { const int idx = 64 * c + lane, db = idx >> 8, row = (idx >> 2) & 63, c4 = idx & 3;
        const v4u w = *(const GAS v4u*)(src + (size_t)row * NPROJ + db * 32 + c4 * 8); *(LAS v4u*)(vl + idx * 16) = w; }
}
__device__ __forceinline__ void gla_g1_unit(Frame& F, int l, int bh, int grp) {
    int tid = F.tid; asm volatile("" : "+v"(tid));
    const int lane = tid & 63, wave = F.wave, i = lane & 31, hh = lane >> 5;
    const int b = bh / 6, h = bh - b * 6, n = grp * 8 + wave;
    const bf16* P = (const bf16*)(KARG(F)->ws + WS_PROJ) + ((size_t)b * SEQ + n * 64) * NPROJ;
    LAS unsigned char* wl = F.lds + RING_OFF + wave * 16384;
    LAS unsigned char* vl = wl; LAS unsigned char* kl = wl + 8192;
    stage_v64(P + VG + h * 64, vl, lane);
#pragma unroll
    for (int c = 0; c < 4; ++c) { const int idx = 64 * c + lane, row = idx >> 2, c4 = idx & 3;
        const v4u w = *(const GAS v4u*)(P + (size_t)row * NPROJ + KG + h * 32 + c4 * 8); *(LAS v4u*)(kl + idx * 16) = w; }
    bf16x8 wfrag;
    { const float* wa2 = KARG(F)->in[I_WA2] + (size_t)l * 16 * 192 + (8 * hh) * 192 + h * 32 + i;
      v4u w; w.x = pk2(wa2[0], wa2[192]); w.y = pk2(wa2[2 * 192], wa2[3 * 192]); w.z = pk2(wa2[4 * 192], wa2[5 * 192]); w.w = pk2(wa2[6 * 192], wa2[7 * 192]); wfrag = as_frag(w); }
    const float bias = KARG(F)->in[I_BA][l * 192 + h * 32 + i];
    float bc[2][16]; float carry = 0.f;
#pragma unroll
    for (int T = 0; T < 2; ++T) {
        const bf16x8 afrag = as_frag(*(const GAS v4u*)(P + (size_t)(32 * T + i) * NPROJ + AG + 8 * hh));
        f32x16 D = {}; D = MFMA32(afrag, wfrag, D);
        float tb[4];
#pragma unroll
        for (int q = 0; q < 4; ++q) { float run = 0.f;
#pragma unroll
            for (int e = 0; e < 4; ++e) { const float x = D[4 * q + e] + bias; run += (fminf(x, 0.f) - __logf(1.0f + __expf(-fabsf(x)))) * (1.0f / 16.0f); bc[T][4 * q + e] = run; }
            tb[q] = run; }
        float off = carry;
#pragma unroll
        for (int q = 0; q < 4; ++q) { const float ob = __shfl_xor(tb[q], 32); const float o = off + (hh ? ob : 0.f);
#pragma unroll
            for (int e = 0; e < 4; ++e) bc[T][4 * q + e] += o;
            off += tb[q] + ob; }
        carry = off;
    }
    const float blast = carry;
    const size_t cidx = (size_t)bh * 32 + n;
    { float* BC = (float*)(KARG(F)->ws + WS_BC) + cidx * 2048;
#pragma unroll
      for (int T = 0; T < 2; ++T)
#pragma unroll
        for (int r = 0; r < 16; ++r) BC[(32 * T + crow(r, hh)) * 32 + i] = bc[T][r]; }
    f32x16 kv0 = {}, kv1 = {};
    const int tro = tr_lane_off(lane);
    bf16x8 af[4], vfr[4][2];
#pragma unroll
    for (int s = 0; s < 4; ++s) { const int T = s >> 1, rb = 8 * (s & 1); float ke[8];
#pragma unroll
        for (int e = 0; e < 8; ++e) { const int t = 32 * T + crow(rb + e, hh); ke[e] = bf1(*(const LAS unsigned short*)(kl + t * 64 + i * 2)) * __expf(blast - bc[T][rb + e]); }
        v4u w; w.x = pk2(ke[0], ke[1]); w.y = pk2(ke[2], ke[3]); w.z = pk2(ke[4], ke[5]); w.w = pk2(ke[6], ke[7]);
        af[s] = as_frag(w); const int t0 = 32 * T + 16 * (s & 1) + 4 * hh;
        vfr[s][0] = tr_frag(vl + t0 * 64 + tro, vl + (t0 + 8) * 64 + tro);
        vfr[s][1] = tr_frag(vl + 4096 + t0 * 64 + tro, vl + 4096 + (t0 + 8) * 64 + tro); }
#pragma unroll
    for (int s = 0; s < 4; ++s) { kv0 = MFMA32(af[s], vfr[s][0], kv0); kv1 = MFMA32(af[s], vfr[s][1], kv1); }
    { LAS float* kvl = (LAS float*)vl;
#pragma unroll
      for (int r = 0; r < 16; ++r) { kvl[crow(r, hh) * 64 + i] = kv0[r]; kvl[crow(r, hh) * 64 + 32 + i] = kv1[r]; }
      if (hh == 0) ((LAS float*)kl)[i] = __expf(blast); }
    __syncthreads();
    {
        const int e0 = tid * 4, si = e0 >> 6;
        float* KV = (float*)(KARG(F)->ws + WS_KVS) + ((size_t)bh * 32 + grp * 8) * 2048 + e0;
        f32x4 agg = {0.f, 0.f, 0.f, 0.f}; float dprod = 1.f;
#pragma unroll
        for (int k = 0; k < 8; ++k) { const LAS unsigned char* wk = F.lds + RING_OFF + k * 16384;
            const f32x4 kvk = *(const LAS f32x4*)(wk + e0 * 4); const float dk = *(const LAS float*)(wk + 8192 + si * 4);
            *(GAS f32x4*)(KV + (size_t)k * 2048) = kvk; agg = agg * dk + kvk; dprod *= dk;
            if ((tid & 15) == 0) ((float*)(KARG(F)->ws + WS_DEC + l * DEC_STRIDE))[((size_t)bh * 32 + grp * 8 + k) * 32 + si] = dk; }
        *(GAS f32x4*)((float*)(KARG(F)->ws + WS_AGS + l * AGS_STRIDE) + ((size_t)bh * 4 + grp) * 2048 + e0) = agg;
        if ((tid & 15) == 0) ((float*)(KARG(F)->ws + WS_AGD + l * AGD_STRIDE))[((size_t)bh * 4 + grp) * 32 + si] = dprod;
    }
    __syncthreads();
}
__device__ __forceinline__ void sg_unit(Frame& F, int l, int b, int n) {
    int lane = F.lane; asm volatile("" : "+v"(lane));
    const int wave = F.wave, c31 = lane & 31, hh = lane >> 5, g = wave >> 1, par = wave & 1;
    const bf16* P = (const bf16*)(KARG(F)->ws + WS_PROJ) + ((size_t)b * SEQ + n * 128) * NPROJ;
    bf16* MIX = (bf16*)(KARG(F)->ws + WS_MIX) + ((size_t)b * SEQ + n * 128) * DMODEL;
    LAS unsigned char* VV = F.lds + RING_OFF;
    const bf16* WSG = (const bf16*)(KARG(F)->ws + WS_WSG) + (size_t)(l * 4 + g) * 128 * 128;
    v4u zv[8], wfr[5][2]; v2u uw[2][8]; float bias[2];
#pragma unroll
    for (int it = 0; it < 8; ++it) zv[it] = *(const GAS v4u*)(P + (size_t)(16 * wave + 2 * it + hh) * NPROJ + ZS + 256 + 8 * c31);
#pragma unroll
    for (int p = 0; p < 5; ++p) { const int tb = par ? (p < 2 ? 1 : 2) : (p == 0 ? 0 : 3), sb = par ? (p < 2 ? p : p - 2) : (p == 0 ? 0 : p - 1);
#pragma unroll
        for (int ks = 0; ks < 2; ++ks) wfr[p][ks] = *(const GAS v4u*)(WSG + (size_t)(32 * tb + c31) * 128 + 32 * sb + 16 * ks + 8 * hh); }
#pragma unroll
    for (int q = 0; q < 2; ++q) { const int t = 32 * (par ? (1 + q) : (3 * q)) + c31;
        bias[q] = KARG(F)->in[I_SGB][(l * 4 + g) * 128 + t];
#pragma unroll
        for (int cg = 0; cg < 8; ++cg) uw[q][cg] = *(const GAS v2u*)(P + (size_t)t * NPROJ + ZS + 64 * g + 32 * (cg >> 2) + 8 * (cg & 3) + 4 * hh); }
    float g8[8], b8[8];
    { const float* lg = KARG(F)->in[I_LNG] + l * 256 + 8 * c31; const float* lb = KARG(F)->in[I_LNB] + l * 256 + 8 * c31;
#pragma unroll
      for (int e = 0; e < 8; ++e) { g8[e] = lg[e]; b8[e] = lb[e]; } }
    asm volatile("s_waitcnt vmcnt(0)" : "+v"(zv[0]), "+v"(zv[1]), "+v"(zv[2]), "+v"(zv[3]), "+v"(zv[4]), "+v"(zv[5]), "+v"(zv[6]), "+v"(zv[7]),
                 "+v"(wfr[0][0]), "+v"(wfr[0][1]), "+v"(wfr[1][0]), "+v"(wfr[1][1]), "+v"(wfr[2][0]), "+v"(wfr[2][1]), "+v"(wfr[3][0]), "+v"(wfr[3][1]), "+v"(wfr[4][0]), "+v"(wfr[4][1]),
                 "+v"(bias[0]), "+v"(bias[1]) :: "memory");
    asm volatile("" : "+v"(uw[0][0]), "+v"(uw[0][1]), "+v"(uw[0][2]), "+v"(uw[0][3]), "+v"(uw[0][4]), "+v"(uw[0][5]), "+v"(uw[0][6]), "+v"(uw[0][7]),
                 "+v"(uw[1][0]), "+v"(uw[1][1]), "+v"(uw[1][2]), "+v"(uw[1][3]), "+v"(uw[1][4]), "+v"(uw[1][5]), "+v"(uw[1][6]), "+v"(uw[1][7]));
    asm volatile("" : "+v"(g8[0]), "+v"(g8[1]), "+v"(g8[2]), "+v"(g8[3]), "+v"(g8[4]), "+v"(g8[5]), "+v"(g8[6]), "+v"(g8[7]), "+v"(b8[0]), "+v"(b8[1]), "+v"(b8[2]), "+v"(b8[3]), "+v"(b8[4]), "+v"(b8[5]), "+v"(b8[6]), "+v"(b8[7]));
#pragma unroll
    for (int it = 0; it < 8; ++it) { const int s = 16 * wave + 2 * it + hh;
        float x[8]; unpack8(zv[it], x); float sum = 0.f;
#pragma unroll
        for (int e = 0; e < 8; ++e) { x[e] = gelu_tanh(x[e]); sum += x[e]; }
#pragma unroll
        for (int o = 1; o < 32; o <<= 1) sum += __shfl_xor(sum, o);
        const float mean = sum * (1.0f / 256.0f); float sq = 0.f;
#pragma unroll
        for (int e = 0; e < 8; ++e) { x[e] -= mean; sq += x[e] * x[e]; }
#pragma unroll
        for (int o = 1; o < 32; o <<= 1) sq += __shfl_xor(sq, o);
        const float rstd = 1.0f / sqrtf(sq * (1.0f / 256.0f) + EPS);
#pragma unroll
        for (int e = 0; e < 8; ++e) x[e] = x[e] * rstd * g8[e] + b8[e];
        v4u o; o.x = pk2(x[0], x[1]); o.y = pk2(x[2], x[3]); o.z = pk2(x[4], x[5]); o.w = pk2(x[6], x[7]);
        *(LAS v4u*)(VV + (c31 >> 3) * 16384 + ((c31 >> 2) & 1) * 8192 + s * 64 + (c31 & 3) * 16) = o; }
    __syncthreads();
    {
        const int tro = tr_lane_off(lane);
        const LAS unsigned char* vg = VV + g * 16384;
        f32x16 Dq[2][2] = {};
        bf16x8 vcur[2][2], vnxt[2][2];
#pragma unroll
        for (int ks = 0; ks < 2; ++ks) { const int s0 = 16 * ks + 8 * hh;
            vcur[ks][0] = tr_frag(vg + s0 * 64 + tro, vg + (s0 + 4) * 64 + tro); vcur[ks][1] = tr_frag(vg + 8192 + s0 * 64 + tro, vg + 8192 + (s0 + 4) * 64 + tro); }
#pragma unroll
        for (int p = 0; p < 5; ++p) {
            if (p < 4) { const int sbn = par ? (p + 1 < 2 ? p + 1 : p - 1) : p;
#pragma unroll
                for (int ks = 0; ks < 2; ++ks) { const int s0 = 32 * sbn + 16 * ks + 8 * hh;
                    vnxt[ks][0] = tr_frag(vg + s0 * 64 + tro, vg + (s0 + 4) * 64 + tro); vnxt[ks][1] = tr_frag(vg + 8192 + s0 * 64 + tro, vg + 8192 + (s0 + 4) * 64 + tro); } }
#pragma unroll
            for (int ks = 0; ks < 2; ++ks) { const bf16x8 wf = as_frag(wfr[p][ks]);
                if (p == 0 || (p == 1 && par)) { Dq[0][0] = MFMA32(vcur[ks][0], wf, Dq[0][0]); Dq[0][1] = MFMA32(vcur[ks][1], wf, Dq[0][1]); }
                else { Dq[1][0] = MFMA32(vcur[ks][0], wf, Dq[1][0]); Dq[1][1] = MFMA32(vcur[ks][1], wf, Dq[1][1]); } }
#pragma unroll
            for (int ks = 0; ks < 2; ++ks) { vcur[ks][0] = vnxt[ks][0]; vcur[ks][1] = vnxt[ks][1]; } }
#pragma unroll
        for (int q = 0; q < 2; ++q) { const int t = 32 * (par ? (1 + q) : (3 * q)) + c31;
#pragma unroll
            for (int cg = 0; cg < 8; ++cg) { const int cb = cg >> 2, g4 = cg & 3, c0 = 32 * cb + 8 * g4 + 4 * hh;
                const float u0 = gelu_tanh(bflo(uw[q][cg].x)), u1 = gelu_tanh(bfhi(uw[q][cg].x)), u2 = gelu_tanh(bflo(uw[q][cg].y)), u3 = gelu_tanh(bfhi(uw[q][cg].y));
                v2u o; o.x = pk2(u0 * (Dq[q][cb][4 * g4] + bias[q]), u1 * (Dq[q][cb][4 * g4 + 1] + bias[q])); o.y = pk2(u2 * (Dq[q][cb][4 * g4 + 2] + bias[q]), u3 * (Dq[q][cb][4 * g4 + 3] + bias[q]));
                *(GAS v2u*)(MIX + (size_t)t * DMODEL + 768 + 64 * g + c0) = o; } }
    }
    __syncthreads();
}
__device__ __forceinline__ void gla_g2_unit(Frame& F, int l, int bh, int grp) {
    int tid = F.tid; asm volatile("" : "+v"(tid));
    const int lane = tid & 63, wave = F.wave, c31 = lane & 31, hh = lane >> 5;
    const int b = bh / 6, h = bh - b * 6;
    LAS unsigned char* ST = F.lds + RING_OFF;
    LAS unsigned char* vl = F.lds + RING_OFF + 32768 + wave * 8192;
    const int n0 = grp * 8;
    {
        const int e0 = tid * 4, si = e0 >> 6, sj = e0 & 63;
        const float* KV = (const float*)(KARG(F)->ws + WS_KVS) + (size_t)bh * 32 * 2048 + e0;
        const float* DEC = (const float*)(KARG(F)->ws + WS_DEC + l * DEC_STRIDE) + (size_t)bh * 32 * 32 + si;
        const float* AGS = (const float*)(KARG(F)->ws + WS_AGS + l * AGS_STRIDE) + (size_t)bh * 4 * 2048 + e0;
        const float* AGD = (const float*)(KARG(F)->ws + WS_AGD + l * AGD_STRIDE) + (size_t)bh * 4 * 32 + si;
        f32x4 ag[3]; float ad[3]; f32x4 kvm[7]; float dm[7];
#pragma unroll
        for (int g = 0; g < 3; ++g) { const int gg = g < grp ? g : 0; ag[g] = *(const GAS f32x4*)(AGS + (size_t)gg * 2048); ad[g] = AGD[gg * 32]; }
#pragma unroll
        for (int k = 0; k < 7; ++k) { kvm[k] = *(const GAS f32x4*)(KV + (size_t)(n0 + k) * 2048); dm[k] = DEC[(n0 + k) * 32]; }
        f32x4 st = {0.f, 0.f, 0.f, 0.f};
#pragma unroll
        for (int g = 0; g < 3; ++g) if (g < grp) st = st * ad[g] + ag[g];
        LAS unsigned char* sp = ST + (sj >> 5) * 2048 + si * 64 + (sj & 31) * 2;
#pragma unroll
        for (int k = 0; k < 8; ++k) {
            v2u w; w.x = pk2(st[0], st[1]); w.y = pk2(st[2], st[3]); *(LAS v2u*)(sp + k * 4096) = w;
            if (k < 7) st = st * dm[k] + kvm[k];
        }
    }
    __syncthreads();
    {
        const int n = n0 + wave;
        const size_t tok0 = (size_t)b * SEQ + n * 64;
        const bf16* P = (const bf16*)(KARG(F)->ws + WS_PROJ) + tok0 * NPROJ;
        bf16* MIX = (bf16*)(KARG(F)->ws + WS_MIX) + tok0 * DMODEL;
        const float* BC = (const float*)(KARG(F)->ws + WS_BC) + ((size_t)bh * 32 + n) * 2048;
        stage_v64(P + VG + h * 64, vl, lane);
        bf16x8 qf[2][2], kf[2][2];
#pragma unroll
        for (int tb = 0; tb < 2; ++tb)
#pragma unroll
            for (int s = 0; s < 2; ++s) { const int t = 32 * tb + c31, i0 = 16 * s + 8 * hh;
                const v4u qw = *(const GAS v4u*)(P + (size_t)t * NPROJ + QG + h * 32 + i0), kw = *(const GAS v4u*)(P + (size_t)t * NPROJ + KG + h * 32 + i0);
                const f32x4 b0 = *(const GAS f32x4*)(BC + t * 32 + i0), b1 = *(const GAS f32x4*)(BC + t * 32 + i0 + 4);
                float q[8], k[8]; unpack8(qw, q); unpack8(kw, k);
#pragma unroll
                for (int e = 0; e < 8; ++e) { const float bb = e < 4 ? b0[e & 3] : b1[e & 3]; q[e] *= 0.17677669529663687f * __expf(bb); k[e] *= __expf(-bb); }
                v4u w; w.x = pk2(q[0], q[1]); w.y = pk2(q[2], q[3]); w.z = pk2(q[4], q[5]); w.w = pk2(q[6], q[7]); qf[tb][s] = as_frag(w);
                w.x = pk2(k[0], k[1]); w.y = pk2(k[2], k[3]); w.z = pk2(k[4], k[5]); w.w = pk2(k[6], k[7]); kf[tb][s] = as_frag(w); }
        const int tro = tr_lane_off(lane);
        f32x16 OT[2][2];
#pragma unroll
        for (int jb = 0; jb < 2; ++jb)
#pragma unroll
            for (int tb = 0; tb < 2; ++tb) OT[jb][tb] = (f32x16){};
        const LAS unsigned char* stw = ST + wave * 4096;
        { bf16x8 sfr[2][2];
#pragma unroll
          for (int jb = 0; jb < 2; ++jb)
#pragma unroll
            for (int s = 0; s < 2; ++s) { const int r0 = 16 * s + 8 * hh; sfr[jb][s] = tr_frag(stw + jb * 2048 + r0 * 64 + tro, stw + jb * 2048 + (r0 + 4) * 64 + tro); }
#pragma unroll
          for (int jb = 0; jb < 2; ++jb)
#pragma unroll
            for (int s = 0; s < 2; ++s)
#pragma unroll
                for (int tb = 0; tb < 2; ++tb) OT[jb][tb] = MFMA32(sfr[jb][s], qf[tb][s], OT[jb][tb]); }
#pragma unroll
        for (int xt = 0; xt < 3; ++xt) { const int sb = xt >> 1, tb = (xt + 1) >> 1;
            f32x16 X = {};
#pragma unroll
            for (int s = 0; s < 2; ++s) X = MFMA32(kf[sb][s], qf[tb][s], X);
            if (sb == tb) {
#pragma unroll
                for (int r = 0; r < 16; ++r) if (crow(r, hh) > c31) X[r] = 0.f; }
            bf16x8 xfr[2], vfx[2][2];
#pragma unroll
            for (int s2 = 0; s2 < 2; ++s2) {
                v4u w; w.x = pk2(X[8 * s2], X[8 * s2 + 1]); w.y = pk2(X[8 * s2 + 2], X[8 * s2 + 3]); w.z = pk2(X[8 * s2 + 4], X[8 * s2 + 5]); w.w = pk2(X[8 * s2 + 6], X[8 * s2 + 7]);
                xfr[s2] = as_frag(w); const int r0 = 32 * sb + 16 * s2 + 4 * hh;
#pragma unroll
                for (int jb = 0; jb < 2; ++jb) vfx[s2][jb] = tr_frag(vl + jb * 4096 + r0 * 64 + tro, vl + jb * 4096 + (r0 + 8) * 64 + tro); }
#pragma unroll
            for (int s2 = 0; s2 < 2; ++s2)
#pragma unroll
                for (int jb = 0; jb < 2; ++jb) OT[jb][tb] = MFMA32(vfx[s2][jb], xfr[s2], OT[jb][tb]); }
        const float* gn = KARG(F)->in[I_GNG] + l * 64;
#pragma unroll
        for (int tb = 0; tb < 2; ++tb) { const int t = 32 * tb + c31; float ss = 0.f;
#pragma unroll
            for (int jb = 0; jb < 2; ++jb)
#pragma unroll
                for (int r = 0; r < 16; ++r) ss += OT[jb][tb][r] * OT[jb][tb][r];
            ss += __shfl_xor(ss, 32);
            const float rstd = 1.0f / sqrtf(ss * (1.0f / 64.0f) + EPS);
#pragma unroll
            for (int jb = 0; jb < 2; ++jb)
#pragma unroll
                for (int g4 = 0; g4 < 4; ++g4) { const int j0 = 32 * jb + 8 * g4 + 4 * hh;
                    const v2u rw = *(const GAS v2u*)(P + (size_t)t * NPROJ + RG + h * 64 + j0); const f32x4 gv = *(const f32x4*)(gn + j0);
                    float rr[4] = {bflo(rw.x), bfhi(rw.x), bflo(rw.y), bfhi(rw.y)}; float y[4];
#pragma unroll
                    for (int e = 0; e < 4; ++e) { const float sl = rr[e] / (1.0f + __expf(-rr[e])); y[e] = OT[jb][tb][4 * g4 + e] * rstd * gv[e] * sl; }
                    v2u o; o.x = pk2(y[0], y[1]); o.y = pk2(y[2], y[3]);
                    *(GAS v2u*)(MIX + (size_t)t * DMODEL + 384 + h * 64 + j0) = o; } }
    }
    __syncthreads();
}
constexpr int ATT_KPITCH = 144, ATT_NKEYS = 384, ATT_VOFF = ATT_NKEYS * ATT_KPITCH  , ATT_VDB = ATT_NKEYS * 64  ;
constexpr int ATT_UNITS = 3 * 1536, ATT_PER_WG = ATT_UNITS / 256;
struct AttUnit { int r, bh, d, rho, I0, sub; };
__device__ __forceinline__ AttUnit att_decode(int bid, int k) {
    const int xl = bid & 7, rk = bid >> 3; AttUnit a; a.r = k / 6; const int v = rk + 32 * (k - 6 * a.r);
    a.bh = 24 * xl + (v >> 3); a.sub = ((v & 7) + k) & 7;
    if (a.r == 0) { a.d = 1; a.rho = 0; a.I0 = 256 * a.sub; } else if (a.r == 1) { a.d = 4; a.rho = a.sub >> 1; a.I0 = 256 * (a.sub & 1); } else { a.d = 16; a.rho = 2 * a.sub; a.I0 = 0; }
    return a;
}
#define ATT_STAGE_LOAD(U, ST) do { const int b_ = (U).bh / 6, h_ = (U).bh - b_ * 6; \
    const bf16* src_ = Pall + (size_t)b_ * SEQ * NPROJ + (skv ? VA : KA) + h_ * 64 + sc8 * 8; \
    _Pragma("unroll") for (int s_ = 0; s_ < 12; ++s_) { \
        int rho_ = (U).rho, ikb_ = (U).I0 - 128 + 32 * s_; if ((U).r == 2) { rho_ += (s_ >> 2) & 1; ikb_ = 32 * (s_ & 3); } \
        ikb_ = ikb_ < 0 ? 0 : ikb_;     \
        ST[s_] = *(const GAS v4u*)(src_ + (size_t)(rho_ + (U).d * (ikb_ + skk)) * NPROJ); } } while (0)
#define ATT_STAGE_WRITE(U, ST) do { \
    _Pragma("unroll") for (int s_ = 0; s_ < 12; ++s_) *(LAS v4u*)(sdst + s_ * (skv ? 32 * 64 : 32 * ATT_KPITCH)) = ST[s_]; } while (0)
#define ATT_Q_LOAD(U, QF) do { const int b_ = (U).bh / 6, h_ = (U).bh - b_ * 6; \
    const int rho_ = (U).rho + ((U).r == 2 ? (wave >> 2) : 0), i0_ = (U).I0 + 32 * ((U).r == 2 ? (wave & 3) : wave); \
    const bf16* qp_ = Pall + ((size_t)b_ * SEQ + rho_ + (U).d * (i0_ + j)) * NPROJ + QA + h_ * 64 + 8 * hh; \
    _Pragma("unroll") for (int s_ = 0; s_ < 4; ++s_) QF[s_] = *(const GAS v4u*)(qp_ + 16 * s_); } while (0)
__device__ __forceinline__ void att_phase(Frame& F, int l) {
    int tid = F.tid; asm volatile("" : "+v"(tid));
    const int lane = tid & 63, wave = F.wave, j = lane & 31, hh = lane >> 5;
    const bf16* Pall = (const bf16*)(KARG(F)->ws + WS_PROJ);
    bf16* OR = l == 0 ? (bf16*)(KARG(F)->ws + WS_OR) : (bf16*)KARG(F)->out; float* LSE = (float*)(KARG(F)->ws + WS_LSE + l * LSE_STRIDE);
    LAS unsigned char* Kimg = F.lds + RING_OFF; LAS unsigned char* Vimg = F.lds + RING_OFF + ATT_VOFF;
    const int skv = tid >> 8, skk = (tid & 255) >> 3, sc8 = tid & 7;
    LAS unsigned char* sdst = skv ? (Vimg + (sc8 >> 2) * ATT_VDB + skk * 64 + (sc8 & 3) * 16) : (Kimg + skk * ATT_KPITCH + sc8 * 16);
    const int tro = tr_lane_off(lane);
    v4u st[12], qn[4];
    int bidq = F.bid; asm volatile("" : "+s"(bidq));
    AttUnit cur = att_decode(bidq, 0);
    ATT_STAGE_LOAD(cur, st); ATT_Q_LOAD(cur, qn);
#pragma unroll 1
    for (int k = 0; k < ATT_PER_WG; ++k) {
        asm volatile("s_waitcnt vmcnt(0)" : "+v"(st[0]), "+v"(st[1]), "+v"(st[2]), "+v"(st[3]), "+v"(st[4]), "+v"(st[5]), "+v"(st[6]), "+v"(st[7]), "+v"(st[8]), "+v"(st[9]), "+v"(st[10]), "+v"(st[11]),
                     "+v"(qn[0]), "+v"(qn[1]), "+v"(qn[2]), "+v"(qn[3]) :: "memory");
        ATT_STAGE_WRITE(cur, st);
        bf16x8 qf[4];
#pragma unroll
        for (int s = 0; s < 4; ++s) qf[s] = as_frag(qn[s]);
        const AttUnit nxt = att_decode(bidq, (k + 1 < ATT_PER_WG) ? k + 1 : k);
        if (k + 1 < ATT_PER_WG) { ATT_STAGE_LOAD(nxt, st); ATT_Q_LOAD(nxt, qn); }
        __syncthreads();
        {
            const int b = cur.bh / 6, h = cur.bh - b * 6;
            const int wq = (cur.r == 2) ? (wave & 3) : wave;
            const int i0 = cur.I0 + 32 * wq, rho = cur.rho + ((cur.r == 2) ? (wave >> 2) : 0);
            const int slot0 = (cur.r == 2) ? ((wave >> 2) * 4 + wq - 4) : wq;
            int kt = (i0 >= 128) ? 0 : ((128 - i0) >> 5);
            f32x16 O0 = {}, O1 = {}; float m = -1e30f, lsum = 0.f;
#pragma unroll 1
            for (; kt < 5; ++kt) {
                bf16x8 kf[4];
                { const LAS unsigned char* kp = Kimg + ((slot0 + kt) * 32 + j) * ATT_KPITCH + hh * 16;
#pragma unroll
                  for (int s = 0; s < 4; ++s) kf[s] = *(const LAS bf16x8*)(kp + 32 * s); }
                f32x16 S = {};
#pragma unroll
                for (int s = 0; s < 4; ++s) S = MFMA32(kf[s], qf[s], S);
                if (kt == 0) {
#pragma unroll
                    for (int r = 0; r < 16; ++r) if (crow(r, hh) < j) S[r] = -1e30f; }
                if (kt == 4) {
#pragma unroll
                    for (int r = 0; r < 16; ++r) if (crow(r, hh) > j) S[r] = -1e30f; }
                float mt = S[0];
#pragma unroll
                for (int r = 1; r < 16; ++r) mt = fmaxf(mt, S[r]);
                mt = fmaxf(mt, __shfl_xor(mt, 32));
                const float mn = fmaxf(m, mt), alpha = __expf(m - mn); m = mn;
                float ps = 0.f;
#pragma unroll
                for (int r = 0; r < 16; ++r) { S[r] = __expf(S[r] - mn); ps += S[r]; }
                lsum = lsum * alpha + ps;
#pragma unroll
                for (int r = 0; r < 16; ++r) { O0[r] *= alpha; O1[r] *= alpha; }
                const LAS unsigned char* vb = Vimg + (slot0 + kt) * 32 * 64 + tro;
                bf16x8 vf[2][2], pf[2];
#pragma unroll
                for (int s2 = 0; s2 < 2; ++s2) { const int r0 = 16 * s2 + 4 * hh;
                    v4u w; w.x = pk2(S[8 * s2], S[8 * s2 + 1]); w.y = pk2(S[8 * s2 + 2], S[8 * s2 + 3]); w.z = pk2(S[8 * s2 + 4], S[8 * s2 + 5]); w.w = pk2(S[8 * s2 + 6], S[8 * s2 + 7]);
                    pf[s2] = as_frag(w);
                    vf[s2][0] = tr_frag(vb + r0 * 64, vb + (r0 + 8) * 64);
                    vf[s2][1] = tr_frag(vb + ATT_VDB + r0 * 64, vb + ATT_VDB + (r0 + 8) * 64); }
#pragma unroll
                for (int s2 = 0; s2 < 2; ++s2) { O0 = MFMA32(vf[s2][0], pf[s2], O0); O1 = MFMA32(vf[s2][1], pf[s2], O1); }
            }
            const float ltot = lsum + __shfl_xor(lsum, 32), inv = 1.0f / ltot, lse = m + __logf(ltot);
            const size_t tok = (size_t)cur.r * M + (size_t)b * SEQ + rho + cur.d * (i0 + j);
            bf16* rp = OR + tok * 384 + h * 64;
#pragma unroll
            for (int g4 = 0; g4 < 4; ++g4) { const int d0 = 8 * g4 + 4 * hh;
                v2u w; w.x = pk2(O0[4 * g4] * inv, O0[4 * g4 + 1] * inv); w.y = pk2(O0[4 * g4 + 2] * inv, O0[4 * g4 + 3] * inv); *(GAS v2u*)(rp + d0) = w;
                w.x = pk2(O1[4 * g4] * inv, O1[4 * g4 + 1] * inv); w.y = pk2(O1[4 * g4 + 2] * inv, O1[4 * g4 + 3] * inv); *(GAS v2u*)(rp + 32 + d0) = w; }
            if (hh == 0) LSE[((size_t)cur.r * 192 + cur.bh) * 2048 + rho * (2048 / cur.d) + i0 + j] = lse;
        }
        __syncthreads();
        cur = nxt;
    }
}
#undef ATT_STAGE_LOAD
#undef ATT_STAGE_WRITE
#undef ATT_Q_LOAD
__device__ __forceinline__ void att_combine(Frame& F, int l) {
    const bf16* OR = l == 0 ? (const bf16*)(KARG(F)->ws + WS_OR) : (const bf16*)KARG(F)->out; const float* LSE = (const float*)(KARG(F)->ws + WS_LSE + l * LSE_STRIDE);
    bf16* MIX = (bf16*)(KARG(F)->ws + WS_MIX);
    int tq = F.tid; asm volatile("" : "+v"(tq));
    const int gt = (F.bid >> 3) * (NWAVES * 64) + tq, tokx = (F.bid & 7) * 8192;
    constexpr int NT = 32 * NWAVES * 64;
#pragma unroll 1
    for (int ib = 0; ib < 6; ++ib) {
        v4u va[4], vb[4], vc[4]; float l0[4], l1[4], l2[4];
#pragma unroll
        for (int u = 0; u < 4; ++u) { const int g = gt + (4 * ib + u) * NT, tl = g / 48, pc = g - tl * 48, hd = pc >> 3, tok = tokx + tl;
            const int bq_ = tok >> 11, p_ = tok & 2047; const size_t lb = (size_t)(bq_ * 6 + hd) * 2048;
            l0[u] = LSE[lb + p_]; l1[u] = LSE[(size_t)192 * 2048 + lb + (p_ & 3) * 512 + (p_ >> 2)]; l2[u] = LSE[(size_t)384 * 2048 + lb + (p_ & 15) * 128 + (p_ >> 4)];
            va[u] = *(const GAS v4u*)(OR + (size_t)tok * 384 + pc * 8); vb[u] = *(const GAS v4u*)(OR + ((size_t)M + tok) * 384 + pc * 8); vc[u] = *(const GAS v4u*)(OR + ((size_t)2 * M + tok) * 384 + pc * 8); }
        asm volatile("s_waitcnt vmcnt(0)" : "+v"(va[0]), "+v"(va[1]), "+v"(va[2]), "+v"(va[3]), "+v"(vb[0]), "+v"(vb[1]), "+v"(vb[2]), "+v"(vb[3]), "+v"(vc[0]), "+v"(vc[1]), "+v"(vc[2]), "+v"(vc[3]),
                     "+v"(l0[0]), "+v"(l0[1]), "+v"(l0[2]), "+v"(l0[3]), "+v"(l1[0]), "+v"(l1[1]), "+v"(l1[2]), "+v"(l1[3]), "+v"(l2[0]), "+v"(l2[1]), "+v"(l2[2]), "+v"(l2[3]) :: "memory");
#pragma unroll
        for (int u = 0; u < 4; ++u) { const int g = gt + (4 * ib + u) * NT, tl = g / 48, pc = g - tl * 48, tok = tokx + tl;
            const float mx = fmaxf(l0[u], fmaxf(l1[u], l2[u])); float w0 = __expf(l0[u] - mx), w1 = __expf(l1[u] - mx), w2 = __expf(l2[u] - mx);
            const float wi = 1.0f / (w0 + w1 + w2); w0 *= wi; w1 *= wi; w2 *= wi;
            float fa[8], fb[8], fc[8]; unpack8(va[u], fa); unpack8(vb[u], fb); unpack8(vc[u], fc);
            float o[8];
#pragma unroll
            for (int e = 0; e < 8; ++e) o[e] = w0 * fa[e] + w1 * fb[e] + w2 * fc[e];
            v4u w; w.x = pk2(o[0], o[1]); w.y = pk2(o[2], o[3]); w.z = pk2(o[4], o[5]); w.w = pk2(o[6], o[7]);
            *(GAS v4u*)(MIX + (size_t)tok * DMODEL + pc * 8) = w; }
    }
}
__global__ void __launch_bounds__(NWAVES * 64, 2) hybrid_fwd(const Args args) {
    extern __shared__ __attribute__((aligned(16))) unsigned char lds[];
    Frame F;
    F.lds = (LAS unsigned char*)lds;
    F.MISC = (volatile LAS unsigned*)(F.lds + MISC_OFF);
    F.tid = threadIdx.x; F.lane = F.tid & 63; F.wave = __builtin_amdgcn_readfirstlane(F.tid >> 6);
    F.G = gridDim.x; F.bid = blockIdx.x;
    F.K = (const CAS Args*)__builtin_amdgcn_kernarg_segment_ptr(); F.ctl = (gu32*)(args.ws + WS_CTL);
    for (int u = F.tid; u < LDS_BYTES / 4; u += NWAVES * 64) ((LAS unsigned*)(F.lds))[u] = 0u;
    __syncthreads();
    XcdBarrier bar; bar.bar = (unsigned*)(F.ctl + CW_BAR) + args.li * XCD_BAR_WORDS; bar.x = 0; bar.st = nullptr;
    if (true) bar = xcd_barrier_post((unsigned*)(F.ctl + CW_BAR) + args.li * XCD_BAR_WORDS, F.MISC + 8);
    const int lo = args.ph_lo, hi = args.ph_hi;
#ifndef REP_P0
#define REP_P0 1
#endif
#ifndef DRY35
#define DRY35 0
#endif
#ifndef REP_P1
#define REP_P1 1
#endif
#ifndef REP_P4
#define REP_P4 1
#endif
#ifndef REP_ATT
#define REP_ATT 1
#endif
#ifndef REP_G2
#define REP_G2 1
#endif
#ifndef REP_G1
#define REP_G1 1
#endif
#ifndef REP_SG
#define REP_SG 1
#endif
#define REPLOOP(N) _Pragma("unroll 1") for (int rep_ = 0, reps_ = __builtin_amdgcn_readfirstlane(N); rep_ < reps_; ++rep_)
#ifndef PH_MASK
#define PH_MASK 127
#endif
#define HASP(j) (((PH_MASK) >> (j)) & 1)
#define IN(k) (lo <= (k) && (k) < hi)
#define SEAM(k) do { if (IN(k) && IN((k) + 1)) xcd_barrier(bar); } while (0)

    if (HASP(0) && IN(0)) { REPLOOP(REP_P0) { p0_prologue(F); __syncthreads(); } SEAM(0); }

    bf16* XB = (bf16*)(KARG(F)->ws + WS_XB);
    bf16* PROJ = (bf16*)(KARG(F)->ws + WS_PROJ); bf16* MIXB = (bf16*)(KARG(F)->ws + WS_MIX); bf16* HID = (bf16*)(KARG(F)->ws + WS_HID);
#pragma unroll
    for (int l = 0; l < DEPTH; ++l) {
        const int pb = 1 + 6 * l;
        unsigned char* wl = KARG(F)->ws + WS_W + (size_t)l * W_LAYER;
        if (HASP(1) && IN(pb)) {
            pg8::Gemm g{XB, (const bf16*)(wl + W_IN), M, NPROJ, DMODEL}; pg8::StaticOrder S; S.init(M, NPROJ, F.G, F.bid);
            pg8::EpiProj E{PROJ, NPROJ, (const float*)(KARG(F)->ws + WS_SSQ + (size_t)(2 * l) * SSQ_STRIDE), KARG(F)->in[I_QNG] + l * 64, KARG(F)->in[I_KNG] + l * 64, (const float*)(KARG(F)->ws + WS_ROPE), 1.0f / DMODEL, EPS};
            REPLOOP(REP_P1) pg8::gemm_phase<pg8::EpiProj, pg8::StaticOrder, true, true>(F.lds + RING_OFF, g, S, E);
            SEAM(pb);
        }
        if (HASP(2) && IN(pb + 1)) {
            REPLOOP(REP_G1) {
#pragma unroll 1
            for (int k = 0; k < 3; ++k) { const int u = (F.bid >> 3) + 32 * k;
            if (u < 96) gla_g1_unit(F, l, 24 * (F.bid & 7) + (u >> 2), u & 3);
            } }
            __syncthreads();
            REPLOOP(REP_SG) {
#pragma unroll 1
            for (int k = 0; k < 2; ++k) { const int u = (F.bid >> 3) + 32 * k;
            if (u < 64) sg_unit(F, l, 4 * (F.bid & 7) + (u >> 4), u & 15);
            } }
            REPLOOP(REP_ATT) { att_phase(F, l); }
            SEAM(pb + 1);
        }
        if (HASP(3) && IN(pb + 2)) {
            att_combine(F, l);
            REPLOOP(REP_G2)
#pragma unroll 1
            for (int k = 0; k < 3; ++k) { const int u = (F.bid >> 3) + 32 * k; if (u < 96) gla_g2_unit(F, l, 24 * (F.bid & 7) + (u >> 2), u & 3); }
            SEAM(pb + 2);
        }
        if (HASP(4) && IN(pb + 3)) {
            pg8::Gemm g{MIXB, (const bf16*)(wl + W_OUT), M, DMODEL, DMODEL}; pg8::StaticOrder S; S.init(M, DMODEL, F.G, F.bid);
            pg8::EpiResidB E{XB, (float*)(KARG(F)->ws + WS_SSQ + (size_t)(2 * l + 1) * SSQ_STRIDE), nullptr, DMODEL};
            pg8::gemm_phase<pg8::EpiResidB, pg8::StaticOrder, true, true>(F.lds + RING_OFF, g, S, E);
            SEAM(pb + 3);
        }
        if (HASP(5) && IN(pb + 4)) {
            pg8::Gemm g{XB, (const bf16*)(wl + W_1), M, FF, DMODEL}; pg8::StaticOrder S; S.init(M, FF, F.G, F.bid);
            pg8::EpiScaleBf16<1> E{HID, FF, (const float*)(KARG(F)->ws + WS_SSQ + (size_t)(2 * l + 1) * SSQ_STRIDE), 1.0f / DMODEL, EPS};
            REPLOOP(REP_P4) pg8::gemm_phase<pg8::EpiScaleBf16<1>, pg8::StaticOrder, true, true>(F.lds + RING_OFF, g, S, E);
            SEAM(pb + 4);
        }
        if (HASP(6) && IN(pb + 5)) {
            pg8::Gemm g{HID, (const bf16*)(wl + W_2), M, DMODEL, FF}; pg8::StaticOrder S; S.init(M, DMODEL, F.G, F.bid);
            pg8::EpiResidB E{XB, (float*)(KARG(F)->ws + WS_SSQ + (size_t)((2 * l + 2) & 3) * SSQ_STRIDE), (l + 1 < DEPTH) ? nullptr : KARG(F)->out, DMODEL};
            pg8::gemm_phase<pg8::EpiResidB, pg8::StaticOrder, true, true>(F.lds + RING_OFF, g, S, E);
            if (l + 1 < DEPTH) SEAM(pb + 5);
        }
    }
#undef IN
#undef SEAM
}

extern "C" void kernel_launch(void* const* d_in, const int* in_sizes, int n_in, void* d_out, int out_size, void* d_ws, size_t ws_size, hipStream_t stream) {
    static int grid = 0;
    if (grid == 0) {
        if (n_in != 16 || in_sizes[0] != M * DMODEL || out_size != M * DMODEL || ws_size < WS_END2) { fprintf(stderr, "kernel_launch: unexpected shapes (n_in %d, in0 %d, out %d, ws %zu); nothing launched\n", n_in, n_in > 0 ? in_sizes[0] : -1, out_size, ws_size); grid = -1; return; }
        int dev = 0, cus = 0, per_cu = 0;
        if (hipGetDevice(&dev) != hipSuccess || hipDeviceGetAttribute(&cus, hipDeviceAttributeMultiprocessorCount, dev) != hipSuccess) { grid = -1; return; }
        if (hipFuncSetAttribute((const void*)hybrid_fwd, hipFuncAttributeMaxDynamicSharedMemorySize, LDS_BYTES) != hipSuccess) { fprintf(stderr, "kernel_launch: hipFuncSetAttribute failed\n"); grid = -1; return; }
        if (hipOccupancyMaxActiveBlocksPerMultiprocessor(&per_cu, (const void*)hybrid_fwd, NWAVES * 64, LDS_BYTES) != hipSuccess || per_cu < 1)
            fprintf(stderr, "kernel_launch: note: occupancy query reports %d workgroups per CU\n", per_cu);
        (void)hipGetLastError();
        grid = cus;
        if (grid != 256) fprintf(stderr, "kernel_launch: %d CUs (built for 256)\n", grid);
        if (grid > 256) grid = 256;
        grid &= ~7;
    }
    if (grid <= 0) return;
    if (hipMemsetAsync((char*)d_ws + WS_CTL, 0, CTL_ZERO_BYTES, stream) != hipSuccess) { fprintf(stderr, "kernel_launch: memset failed\n"); return; }
    Args a{};
    for (int i = 0; i < 16; ++i) a.in[i] = (const float*)d_in[i];
    a.out = (float*)d_out; a.ws = (unsigned char*)d_ws;
    int lo_ = 0, li = 0;
    for (int p = 0; p < NPHASE; ++p) {
        const int ty = (p == 0) ? 0 : ((p - 1) % 6) + 1;
        const bool cut = (p == NPHASE - 1) || ((CUTMASK >> ty) & 1);
        if (!cut) continue;
        a.li = li; a.ph_lo = lo_; a.ph_hi = p + 1; lo_ = p + 1;
        hipLaunchKernelGGL(hybrid_fwd, dim3(grid), dim3(NWAVES * 64), LDS_BYTES, stream, a);
        const hipError_t le = hipPeekAtLastError();
        if (le != hipSuccess) { fprintf(stderr, "kernel_launch: launch %d failed: %s\n", li, hipGetErrorName(le)); break; }
        ++li;
    }
}
```
